# Optimizing an MI355X kernel written in HIP

```python
import math
import jax, jax.numpy as jnp
from jax import lax
import numpy as np


D_MODEL = 1024
BATCH = 8
SEQ = 4096
DEPTH = 4

D_ATTN = D_MODEL // 2
HEAD_DIM = 64
N_HEADS = D_ATTN // HEAD_DIM
ROPE_DIM = HEAD_DIM // 4
ROPE_THETA = 500000.0
DILATED_PATTERNS = ((128, 1), (512, 4), (2048, 16))
D_SSM = D_MODEL - D_ATTN
SSM_GROUP = 16
N_SSM_GROUPS = D_SSM // SSM_GROUP
SSM_STATE = 64
DT_MIN = 0.001
DT_MAX = 0.1
D_MIX = D_ATTN + D_SSM
D_IN_PROJ = 3 * D_ATTN + D_SSM
D_FF = 128 * (-(-(8 * D_MODEL // 3) // 128))
PLE_DIM = 256
NORM_EPS = 1e-6

kernel_name = 'hybrid_s5_dilated_macaron_block'


def rms_norm(x, g):
    xf = x.astype(jnp.float32)
    y = xf * lax.rsqrt(jnp.mean(xf * xf, axis=-1, keepdims=True) + NORM_EPS)
    return (y * g.astype(jnp.float32)).astype(x.dtype)


def swiglu(x, w_gate, w_up, w_down):
    return (jax.nn.silu(x @ w_gate) * (x @ w_up)) @ w_down


def partial_rotary(t, positions):
    half = ROPE_DIM // 2
    inv_freq = ROPE_THETA ** (-jnp.arange(half, dtype=jnp.float32) * (2.0 / ROPE_DIM))
    ang = positions.astype(jnp.float32)[:, :, None, None] * inv_freq
    cos, sin = jnp.cos(ang), jnp.sin(ang)
    tf = t.astype(jnp.float32)
    t1, t2, rest = tf[..., :half], tf[..., half:ROPE_DIM], tf[..., ROPE_DIM:]
    out = jnp.concatenate([t1 * cos - t2 * sin, t2 * cos + t1 * sin, rest], axis=-1)
    return out.astype(t.dtype)


def dilated_band_attention(q, k, v, window, dilation):
    b_, s_, h_, dh = q.shape
    band = window // dilation
    n_str = s_ // dilation
    nb = -(-n_str // band)
    lp = nb * band
    nrows = b_ * dilation

    def to_blocks(t):
        t = t.reshape(b_, n_str, dilation, h_, dh).transpose(0, 2, 1, 3, 4).reshape(nrows, n_str, h_, dh)
        t = jnp.pad(t, ((0, 0), (0, lp - n_str), (0, 0), (0, 0)))
        return t.reshape(nrows, nb, band, h_, dh)

    def with_prev(t):
        prev = jnp.pad(t[:, :-1], ((0, 0), (1, 0), (0, 0), (0, 0), (0, 0)))
        return jnp.concatenate([prev, t], axis=2)

    qb = to_blocks(q)
    kc = with_prev(to_blocks(k))
    vc = with_prev(to_blocks(v))
    scores = jnp.einsum('nbqhd,nbkhd->nbhqk', qb, kc).astype(jnp.float32) * (HEAD_DIM ** -0.5)
    qi = jnp.arange(band)[:, None]
    kj = jnp.arange(2 * band)[None, :]
    dist = qi + band - kj
    band_ok = (dist >= 0) & (dist <= band)
    blk = jnp.arange(nb)[:, None, None]
    mask = band_ok[None] & ((blk > 0) | (kj >= band)[None])
    scores = jnp.where(mask[None, :, None], scores, -jnp.inf)
    m = jnp.max(scores, axis=-1, keepdims=True)
    e = jnp.exp(scores - m)
    den = jnp.sum(e, axis=-1, keepdims=True)
    probs = (e / den).astype(v.dtype)
    out = jnp.einsum('nbhqk,nbkhd->nbqhd', probs, vc).astype(jnp.float32)
    lse = (m + jnp.log(den))[..., 0]
    out = out.reshape(nrows, lp, h_, dh)[:, :n_str]
    out = out.reshape(b_, dilation, n_str, h_, dh).transpose(0, 2, 1, 3, 4).reshape(b_, s_, h_, dh)
    lse = lse.transpose(0, 1, 3, 2).reshape(nrows, lp, h_)[:, :n_str]
    lse = lse.reshape(b_, dilation, n_str, h_).transpose(0, 2, 1, 3).reshape(b_, s_, h_)
    return out, lse


def dilated_mixture_attention(q, k, v):
    outs, lses = [], []
    for window, dilation in DILATED_PATTERNS:
        o, l = dilated_band_attention(q, k, v, window, dilation)
        outs.append(o)
        lses.append(l)
    wts = jax.nn.softmax(jnp.stack(lses, axis=0), axis=0)
    out = jnp.sum(wts[..., None] * jnp.stack(outs, axis=0), axis=0)
    b_, s_ = q.shape[0], q.shape[1]
    return out.reshape(b_, s_, D_ATTN).astype(q.dtype)


def s5_mixer(u, lam_re, lam_im, log_dt, b_re, b_im, c_re, c_im, d_skip, w_glu, b_glu):
    b_, s_ = u.shape[0], u.shape[1]
    uf = u.astype(jnp.float32).reshape(b_, s_, N_SSM_GROUPS, SSM_GROUP)
    lam = lax.complex(lam_re.astype(jnp.float32), lam_im.astype(jnp.float32))
    dt = jnp.exp(log_dt.astype(jnp.float32))[:, None]
    lam_bar = jnp.exp(lam * dt)
    b_mat = lax.complex(b_re.astype(jnp.float32), b_im.astype(jnp.float32))
    b_bar = ((lam_bar - 1.0) / lam)[..., None] * b_mat
    bu = jnp.einsum('bsgh,gph->bsgp', uf.astype(jnp.complex64), b_bar)
    a = jnp.broadcast_to(lam_bar, bu.shape)

    def combine(left, right):
        a_l, x_l = left
        a_r, x_r = right
        return a_r * a_l, a_r * x_l + x_r

    _, states = lax.associative_scan(combine, (a, bu), axis=1)
    c_mat = lax.complex(c_re.astype(jnp.float32), c_im.astype(jnp.float32))
    y = jnp.real(jnp.einsum('bsgp,ghp->bsgh', states, c_mat)) + d_skip.astype(jnp.float32) * uf
    y = jax.nn.gelu(y).reshape(b_, s_, D_SSM)
    y = y * jax.nn.sigmoid(y @ w_glu.astype(jnp.float32) + b_glu.astype(jnp.float32))
    return y.astype(u.dtype)


def setup_inputs(seed: int = 0) -> dict:
    key = jax.random.key(seed)
    ks = jax.random.split(key, 40)
    f32 = jnp.float32

    def nrm(k, shape, fan_in):
        return jax.random.normal(k, shape, f32) * (fan_in ** -0.5)

    def gain(k, shape):
        return 1.0 + 0.05 * jax.random.normal(k, shape, f32)

    lam_im_base = jnp.pi * jnp.arange(SSM_STATE, dtype=f32)
    return {
        'x': jax.random.normal(ks[0], (BATCH, SEQ, D_MODEL), f32),
        'p': jax.random.normal(ks[1], (DEPTH, BATCH, SEQ, PLE_DIM), f32),
        'positions': (jax.random.randint(ks[2], (BATCH, 1), 0, 1024, dtype=jnp.int32)
                      + jnp.arange(SEQ, dtype=jnp.int32)[None, :]),
        'ffn1_pre_g': gain(ks[3], (DEPTH, D_MODEL)),
        'ffn1_w_gate': nrm(ks[4], (DEPTH, D_MODEL, D_FF), D_MODEL),
        'ffn1_w_up': nrm(ks[5], (DEPTH, D_MODEL, D_FF), D_MODEL),
        'ffn1_w_down': nrm(ks[6], (DEPTH, D_FF, D_MODEL), D_FF),
        'ffn1_post_g': gain(ks[7], (DEPTH, D_MODEL)),
        'mix_pre_g': gain(ks[8], (DEPTH, D_MODEL)),
        'w_in': nrm(ks[9], (DEPTH, D_MODEL, D_IN_PROJ), D_MODEL),
        'attn_norm_g': gain(ks[10], (DEPTH, D_ATTN)),
        'ssm_lam_re': -0.5 + 0.01 * jax.random.normal(ks[11], (DEPTH, N_SSM_GROUPS, SSM_STATE), f32),
        'ssm_lam_im': lam_im_base + 0.01 * jax.random.normal(ks[12], (DEPTH, N_SSM_GROUPS, SSM_STATE), f32),
        'ssm_log_dt': jax.random.uniform(ks[13], (DEPTH, N_SSM_GROUPS), f32,
                                         minval=math.log(DT_MIN), maxval=math.log(DT_MAX)),
        'ssm_b_re': nrm(ks[14], (DEPTH, N_SSM_GROUPS, SSM_STATE, SSM_GROUP), 2 * SSM_GROUP),
        'ssm_b_im': nrm(ks[15], (DEPTH, N_SSM_GROUPS, SSM_STATE, SSM_GROUP), 2 * SSM_GROUP),
        'ssm_c_re': nrm(ks[16], (DEPTH, N_SSM_GROUPS, SSM_GROUP, SSM_STATE), 2 * SSM_STATE),
        'ssm_c_im': nrm(ks[17], (DEPTH, N_SSM_GROUPS, SSM_GROUP, SSM_STATE), 2 * SSM_STATE),
        'ssm_d': jax.random.normal(ks[18], (DEPTH, N_SSM_GROUPS, SSM_GROUP), f32),
        'ssm_w_glu': nrm(ks[19], (DEPTH, D_SSM, D_SSM), D_SSM),
        'ssm_b_glu': 0.01 * jax.random.normal(ks[20], (DEPTH, D_SSM), f32),
        'ssm_norm_g': gain(ks[21], (DEPTH, D_SSM)),
        'w_out': nrm(ks[22], (DEPTH, D_MIX, D_MODEL), D_MIX),
        'mix_post_g': gain(ks[23], (DEPTH, D_MODEL)),
        'ffn2_pre_g': gain(ks[24], (DEPTH, D_MODEL)),
        'ffn2_w_gate': nrm(ks[25], (DEPTH, D_MODEL, D_FF), D_MODEL),
        'ffn2_w_up': nrm(ks[26], (DEPTH, D_MODEL, D_FF), D_MODEL),
        'ffn2_w_down': nrm(ks[27], (DEPTH, D_FF, D_MODEL), D_FF),
        'ffn2_post_g': gain(ks[28], (DEPTH, D_MODEL)),
        'ple_w_up': nrm(ks[29], (DEPTH, PLE_DIM, D_MODEL), PLE_DIM),
        'ple_w_gate': nrm(ks[30], (DEPTH, D_MODEL, D_MODEL), D_MODEL),
        'ple_post_g': gain(ks[31], (DEPTH, D_MODEL)),
    }


def reference(x, p, positions,
              ffn1_pre_g, ffn1_w_gate, ffn1_w_up, ffn1_w_down, ffn1_post_g,
              mix_pre_g, w_in, attn_norm_g,
              ssm_lam_re, ssm_lam_im, ssm_log_dt, ssm_b_re, ssm_b_im, ssm_c_re, ssm_c_im,
              ssm_d, ssm_w_glu, ssm_b_glu, ssm_norm_g, w_out, mix_post_g,
              ffn2_pre_g, ffn2_w_gate, ffn2_w_up, ffn2_w_down, ffn2_post_g,
              ple_w_up, ple_w_gate, ple_post_g):
    b_, s_ = x.shape[0], x.shape[1]
    h = x
    for i in range(DEPTH):
        f = swiglu(rms_norm(h, ffn1_pre_g[i]), ffn1_w_gate[i], ffn1_w_up[i], ffn1_w_down[i])
        h = h + 0.5 * rms_norm(f, ffn1_post_g[i])

        a_in = rms_norm(h, mix_pre_g[i])
        proj = a_in @ w_in[i]
        q, k, v, u = jnp.split(proj, [D_ATTN, 2 * D_ATTN, 3 * D_ATTN], axis=-1)
        q = partial_rotary(q.reshape(b_, s_, N_HEADS, HEAD_DIM), positions)
        k = partial_rotary(k.reshape(b_, s_, N_HEADS, HEAD_DIM), positions)
        v = v.reshape(b_, s_, N_HEADS, HEAD_DIM)
        attn = dilated_mixture_attention(q, k, v)
        ssm = s5_mixer(u, ssm_lam_re[i], ssm_lam_im[i], ssm_log_dt[i], ssm_b_re[i], ssm_b_im[i],
                       ssm_c_re[i], ssm_c_im[i], ssm_d[i], ssm_w_glu[i], ssm_b_glu[i])
        mixed = jnp.concatenate([rms_norm(attn, attn_norm_g[i]), rms_norm(ssm, ssm_norm_g[i])], axis=-1)
        h = h + rms_norm(mixed @ w_out[i], mix_post_g[i])

        f = swiglu(rms_norm(h, ffn2_pre_g[i]), ffn2_w_gate[i], ffn2_w_up[i], ffn2_w_down[i])
        h = h + 0.5 * rms_norm(f, ffn2_post_g[i])

        ple = (p[i] @ ple_w_up[i]) * jax.nn.sigmoid(h @ ple_w_gate[i])
        h = h + rms_norm(ple, ple_post_g[i])
    return h
```

```cpp
#include <hip/hip_runtime.h>
#include <hip/hip_cooperative_groups.h>
#include <cstdio>
#include <cstdint>
namespace cg = cooperative_groups;

#define LAS __attribute__((address_space(3)))
#define PG8_LAS LAS
typedef unsigned short bf16_t;
typedef short bf16x8 __attribute__((ext_vector_type(8)));
typedef float f32x4 __attribute__((ext_vector_type(4)));
typedef float f32x2 __attribute__((ext_vector_type(2)));
typedef unsigned u32x4 __attribute__((ext_vector_type(4)));
typedef unsigned u32x2 __attribute__((ext_vector_type(2)));

constexpr int NB = 8, SEQ = 4096, DM = 1024, MT = NB * SEQ, DEPTH = 4, DATT = 512, NHEAD = 8, DSSM = 512, NGRP = 32, NSTATE = 64;
constexpr int DFF = 2816, DIN = 2048, PLE = 256, QKVW = 1536;
constexpr int CH = 32, NCH = MT / CH  , KT = 640  ;
constexpr float EPS = 1e-6f;
constexpr int NTHREADS = 512, LDS_BYTES = 131072 + 64 + 5120;
constexpr int LDS_TAB = 131072 + 64;

constexpr size_t MiB = (size_t)1 << 20;
constexpr size_t WS_XN = 0, WS_F = 64 * MiB, WS_PB = 128 * MiB, WS_ROT = 144 * MiB, WS_W = 146 * MiB, WS_BIG = 216 * MiB, WS_EXCH = 531 * MiB, WS_HB = WS_F, WS_RS = 534 * MiB, WS_END = 536 * MiB;
constexpr size_t X_B1 = 0, X_B2 = 1024 * 1024, X_CNT = 2048 * 1024, X_BAR = 2048 * 1024 + 65536;
constexpr size_t W_GU1 = 0, W_D1 = 11534336, W_IN = 17301504, W_GLU = 21495808, W_OUT = 22020096, W_GU2 = 24117248, W_D2 = 35651584, W_PUP = 41418752, W_PG = 41943040,
                 W_T = 44040192, W_W1 = 65011712;
constexpr size_t B_ACT = 0, B_QKV = 0, B_AP = 96 * MiB, B_SLOC = 136 * MiB, B_YG = 152 * MiB, B_SSMO = 184 * MiB, B_AO = 216 * MiB, B_LSE = 312 * MiB;

struct Args { const float* in[32]; float* out; unsigned char* ws; };
typedef const __attribute__((address_space(4))) unsigned char* KA;
typedef const float* cfptr_t; typedef unsigned char* ucptr_t; typedef float* fptr_t;
__device__ __forceinline__ KA kargs() { KA k = (KA)__builtin_amdgcn_kernarg_segment_ptr(); asm volatile("" : "+s"(k)); return k; }
__device__ __forceinline__ const float* kin(KA k, int i) { return *(const __attribute__((address_space(4))) cfptr_t*)(k + 8 * i); }
__device__ __forceinline__ float* kout(KA k) { return *(const __attribute__((address_space(4))) fptr_t*)(k + 256); }
__device__ __forceinline__ unsigned char* kws(KA k) { return *(const __attribute__((address_space(4))) ucptr_t*)(k + 264); }

__device__ __forceinline__ unsigned cvt_pk_bf16(float lo, float hi) { unsigned r; asm volatile("v_cvt_pk_bf16_f32 %0, %1, %2" : "=v"(r) : "v"(lo), "v"(hi)); return r; }
__device__ __forceinline__ float bf_lo(unsigned w) { return __uint_as_float(w << 16); }
__device__ __forceinline__ float bf_hi(unsigned w) { return __uint_as_float(w & 0xffff0000u); }
__device__ __forceinline__ bf16_t f2bf(float f) { unsigned u = __float_as_uint(f); u += 0x7FFFu + ((u >> 16) & 1u); return (bf16_t)(u >> 16); }
__device__ __forceinline__ float shx(float v, int mask, int lane) { return __int_as_float(__builtin_amdgcn_ds_bpermute((lane ^ mask) << 2, __float_as_int(v))); }
__device__ __forceinline__ float wave_sum(float v, int lane) {
#pragma unroll
    for (int o = 1; o < 64; o <<= 1) v += shx(v, o, lane);
    return v;
}
__device__ __forceinline__ float fsigmoid(float x) { return __builtin_amdgcn_rcpf(1.0f + __builtin_amdgcn_exp2f(-1.44269504f * x)); }
__device__ __forceinline__ u32x4 pack8(const f32x4 a, const f32x4 b) { u32x4 w; w.x = cvt_pk_bf16(a[0], a[1]); w.y = cvt_pk_bf16(a[2], a[3]); w.z = cvt_pk_bf16(b[0], b[1]); w.w = cvt_pk_bf16(b[2], b[3]); return w; }
__device__ __forceinline__ void unpack8(const u32x4 w, f32x4& a, f32x4& b) { a = (f32x4){bf_lo(w.x), bf_hi(w.x), bf_lo(w.y), bf_hi(w.y)}; b = (f32x4){bf_lo(w.z), bf_hi(w.z), bf_lo(w.w), bf_hi(w.w)}; }
__device__ __forceinline__ int opaque_tid(int wv) { unsigned m = ~0u; asm volatile("" : "+s"(m)); int t = wv * 64 + (int)__builtin_amdgcn_mbcnt_hi(m, __builtin_amdgcn_mbcnt_lo(m, 0u)); asm volatile("" : "+v"(t)); return t; }
#define LDS_FENCE() asm volatile("s_waitcnt lgkmcnt(0)" ::: "memory")

constexpr int BM = 256, BK = 64, HALF = 128, HTB = HALF * BK * 2  , STAGE_BYTES = 8 * HTB, NXCD = 8, WGM = 8;
__host__ __device__ __forceinline__ int lds_byte(int r, int c) { const int st = (r >> 4) * 2 + (c >> 5), rr = r & 15, cc = c & 31, ob = rr * 64 + cc * 2; return st * 1024 + (ob ^ (((ob >> 9) & 1) << 5)); }
__host__ __device__ __forceinline__ void stage_rc(int b, int& R, int& C) { const int st = b / 1024, sb = b % 1024, swz = sb ^ (((sb >> 9) & 1) << 5); R = (st >> 1) * 16 + swz / 64; C = (st & 1) * 32 + (swz % 64) / 2; }
__host__ __device__ __forceinline__ int perm32(int rho) { const int n = rho >> 4, i = rho & 15; return 8 * (i >> 2) + 4 * n + (i & 3); }

struct Unit { int pm, pn, z; };
struct Gemm { const bf16_t* A; const bf16_t* Bt; int lda, ldb, K; size_t zA, zB; };

struct StaticOrder {
    int nM, nN, nwg, G, c;
    __device__ void init(int M, int N, int G_, int c_) { nM = M / BM; nN = N / BM; nwg = nM * nN; G = G_; c = c_; }
    __device__ bool next(int i, Unit& u) const {
        const long L = (long)i * G + c; if (L >= nwg) return false;
        int wgid = (int)L; { const int q = nwg / NXCD, r = nwg % NXCD, xcd = wgid % NXCD, off = wgid / NXCD; wgid = (xcd < r ? xcd * (q + 1) : r * (q + 1) + (xcd - r) * q) + off; }
        const int nig = WGM * nN, gid = wgid / nig, fm = gid * WGM, gsz = (nM - fm) < WGM ? (nM - fm) : WGM;
        u.pm = fm + ((wgid % nig) % gsz); u.pn = (wgid % nig) / gsz; u.z = 0; return true;
    }
    __device__ __forceinline__ void a_ready(const Unit&) const {}
    __device__ __forceinline__ void done(const Unit&) const {}
};
struct OwnTOrder {
    int z, pm, active;
    __device__ bool next(int i, Unit& u) const { if (!active || i >= 2) return false; u.z = z; u.pm = pm; u.pn = i; return true; }
    __device__ __forceinline__ void a_ready(const Unit&) const {}
    __device__ __forceinline__ void done(const Unit&) const {}
};
struct BatchOrder {
    int nM, nN, nZ, G, c;
    __device__ bool next(int i, Unit& u) const {
        const int L = i * G + c, per = nM * nN; if (L >= per * nZ) return false;
        u.z = L / per; const int t = L % per; u.pm = t % nM; u.pn = t / nM; return true;
    }
    __device__ __forceinline__ void a_ready(const Unit&) const {}
    __device__ __forceinline__ void done(const Unit&) const {}
};
typedef f32x4 AccT[2][2][4][2];


__device__ __forceinline__ f32x4 row_part4(const float* rs16, int r, int fq) { return *(const f32x4*)(rs16 + (size_t)r * 16 + 4 * fq); }
__device__ __forceinline__ float row_rstd4(const f32x4 p, int lane) { float t = (p[0] + p[1]) + (p[2] + p[3]); t += shx(t, 16, lane); t += shx(t, 32, lane); return 1.0f / sqrtf(t * (1.0f / DM) + EPS); }
struct EpiBf16 {
    static constexpr bool PERM = true, AFTER_DRAIN = false;
    bf16_t* O; int ldc;
    __device__ __forceinline__ void operator()(const AccT& acc, const Unit& u, int wr, int wc, int fr, int fq) const {
        const int row0 = u.pm * BM + wr * 64 + fr, col0 = u.pn * BM + wc * 32 + 8 * fq;
#pragma unroll
        for (int ai = 0; ai < 2; ++ai)
#pragma unroll
            for (int m = 0; m < 4; ++m) { bf16_t* rowp = O + (size_t)(row0 + ai * HALF + m * 16) * ldc + col0;
#pragma unroll
                for (int bj = 0; bj < 2; ++bj) *(u32x4*)(rowp + bj * HALF) = pack8(acc[ai][bj][m][0], acc[ai][bj][m][1]); }
    }
};
struct EpiSwiglu {
    static constexpr bool PERM = true, AFTER_DRAIN = false;
    bf16_t* O; const float* rs16;
    __device__ __forceinline__ void operator()(const AccT& acc, const Unit& u, int wr, int wc, int fr, int fq) const {
        const int row0 = u.pm * BM + wr * 64 + fr, col0 = u.pn * HALF + wc * 32 + 8 * fq, lane = fq * 16 + fr;
        f32x4 rp[2][4];
#pragma unroll
        for (int ai = 0; ai < 2; ++ai)
#pragma unroll
            for (int m = 0; m < 4; ++m) rp[ai][m] = row_part4(rs16, row0 + ai * HALF + m * 16, fq);
#pragma unroll
        for (int ai = 0; ai < 2; ++ai)
#pragma unroll
            for (int m = 0; m < 4; ++m) { bf16_t* rowp = O + (size_t)(row0 + ai * HALF + m * 16) * DFF + col0; const float rr = row_rstd4(rp[ai][m], lane);
                f32x4 o0, o1;
#pragma unroll
                for (int j = 0; j < 4; ++j) { const float g0 = acc[ai][0][m][0][j] * rr, g1 = acc[ai][0][m][1][j] * rr;
                    o0[j] = g0 * fsigmoid(g0) * (acc[ai][1][m][0][j] * rr); o1[j] = g1 * fsigmoid(g1) * (acc[ai][1][m][1][j] * rr); }
                *(u32x4*)rowp = pack8(o0, o1); }
    }
};
struct EpiWin {
    static constexpr bool PERM = true, AFTER_DRAIN = false;
    bf16_t* qkv; bf16_t* Ap; const f32x4* rot; const float* rs16;
    __device__ __forceinline__ void operator()(const AccT& acc, const Unit& u, int wr, int wc, int fr, int fq) const {
        const int row0 = u.pm * BM + wr * 64 + fr, lane = fq * 16 + fr;
        const int sec = u.pn >> 1;
        f32x4 rp[2][4];
#pragma unroll
        for (int ai = 0; ai < 2; ++ai)
#pragma unroll
            for (int m = 0; m < 4; ++m) rp[ai][m] = row_part4(rs16, row0 + ai * HALF + m * 16, fq);
        if (sec < 2) {
            const bool rotw = (wc & 1) == 0;
            const float sc = sec == 0 ? 0.18033688011112042f : 1.0f;
            const float sg = fq == 0 ? -1.0f : 1.0f;
#pragma unroll
            for (int ai = 0; ai < 2; ++ai)
#pragma unroll
                for (int m = 0; m < 4; ++m) { const int r = row0 + ai * HALF + m * 16; const float rr = row_rstd4(rp[ai][m], lane);
                    f32x4 cs[4];
#pragma unroll
                    for (int i = 0; i < 4; ++i) cs[i] = rotw ? rot[(size_t)r * 4 + i] : (f32x4){1.f, 0.f, 1.f, 0.f};
#pragma unroll
                    for (int bj = 0; bj < 2; ++bj) { f32x4 v0 = acc[ai][bj][m][0] * rr, v1 = acc[ai][bj][m][1] * rr;
                        if (rotw) {
#pragma unroll
                            for (int j = 0; j < 4; ++j) { const float p0 = shx(v0[j], 16, lane), p1 = shx(v1[j], 16, lane);
                                const float c0 = cs[j >> 1][(j & 1) * 2], s0 = cs[j >> 1][(j & 1) * 2 + 1], c1 = cs[2 + (j >> 1)][(j & 1) * 2], s1 = cs[2 + (j >> 1)][(j & 1) * 2 + 1];
                                const float r0 = v0[j] * c0 + sg * p0 * s0, r1 = v1[j] * c1 + sg * p1 * s1;
                                if (fq < 2) { v0[j] = r0; v1[j] = r1; } } }
                        v0 *= sc; v1 *= sc;
                        *(u32x4*)(qkv + (size_t)r * QKVW + u.pn * BM + bj * HALF + wc * 32 + 8 * fq) = pack8(v0, v1); } }
        } else if (sec == 2) {
#pragma unroll
            for (int ai = 0; ai < 2; ++ai)
#pragma unroll
                for (int m = 0; m < 4; ++m) { const int r = row0 + ai * HALF + m * 16; const float rr = row_rstd4(rp[ai][m], lane);
#pragma unroll
                    for (int bj = 0; bj < 2; ++bj) *(u32x4*)(qkv + (size_t)r * QKVW + u.pn * BM + bj * HALF + wc * 32 + 8 * fq) = pack8(acc[ai][bj][m][0] * rr, acc[ai][bj][m][1] * rr); }
        } else {
#pragma unroll
            for (int ai = 0; ai < 2; ++ai)
#pragma unroll
                for (int m = 0; m < 4; ++m) { const int r = row0 + ai * HALF + m * 16; const int R = r >> 5, sp = r & 31; const float rr = row_rstd4(rp[ai][m], lane);
#pragma unroll
                    for (int bj = 0; bj < 2; ++bj) { const int cu = (u.pn - 6) * BM + bj * HALF + wc * 32 + 8 * fq; const int g = cu >> 4, hh = cu & 15;
                        *(u32x4*)(Ap + ((size_t)g * NCH + R) * KT + sp * 16 + hh) = pack8(acc[ai][bj][m][0] * rr, acc[ai][bj][m][1] * rr); } }
        }
    }
};
struct EpiSloc {
    static constexpr bool PERM = false, AFTER_DRAIN = false;
    float* S;
    __device__ __forceinline__ void operator()(const AccT& acc, const Unit& u, int wr, int wc, int fr, int fq) const {
        const int row0 = u.pm * BM + wr * 64 + fr;
#pragma unroll
        for (int ai = 0; ai < 2; ++ai)
#pragma unroll
            for (int m = 0; m < 4; ++m) { float* rowp = S + ((size_t)u.z * NCH + row0 + ai * HALF + m * 16) * 128 + wc * 32 + 4 * fq;
#pragma unroll
                for (int n = 0; n < 2; ++n) *(f32x4*)(rowp + n * 16) = acc[ai][0][m][n]; }
    }
};
struct EpiT {
    static constexpr bool PERM = true, AFTER_DRAIN = false;
    bf16_t* Y;
    __device__ __forceinline__ void operator()(const AccT& acc, const Unit& u, int wr, int wc, int fr, int fq) const {
        const int row0 = u.pm * BM + wr * 64 + fr;
#pragma unroll
        for (int ai = 0; ai < 2; ++ai)
#pragma unroll
            for (int m = 0; m < 4; ++m) { const int R = row0 + ai * HALF + m * 16;
#pragma unroll
                for (int bj = 0; bj < 2; ++bj) { const int c = u.pn * BM + bj * HALF + wc * 32 + 8 * fq; const int tau = c >> 4, hh = c & 15;
                    f32x4 o0, o1;
#pragma unroll
                    for (int j = 0; j < 4; ++j) { const float x0 = acc[ai][bj][m][0][j], x1 = acc[ai][bj][m][1][j];
                        o0[j] = x0 * fsigmoid(1.5957691216f * (x0 + 0.044715f * x0 * x0 * x0)); o1[j] = x1 * fsigmoid(1.5957691216f * (x1 + 0.044715f * x1 * x1 * x1)); }
                    *(u32x4*)(Y + ((size_t)R * CH + tau) * DSSM + u.z * 16 + hh) = pack8(o0, o1); } }
    }
};
struct EpiGlu {
    static constexpr bool PERM = true, AFTER_DRAIN = false;
    const bf16_t* Y; const float* bias; bf16_t* O;
    __device__ __forceinline__ void operator()(const AccT& acc, const Unit& u, int wr, int wc, int fr, int fq) const {
        const int row0 = u.pm * BM + wr * 64 + fr, col0 = u.pn * BM + wc * 32 + 8 * fq;
#pragma unroll
        for (int ai = 0; ai < 2; ++ai)
#pragma unroll
            for (int m = 0; m < 4; ++m) { const size_t off = (size_t)(row0 + ai * HALF + m * 16) * DSSM + col0;
#pragma unroll
                for (int bj = 0; bj < 2; ++bj) { const f32x4 b0 = *(const f32x4*)(bias + col0 + bj * HALF), b1 = *(const f32x4*)(bias + col0 + bj * HALF + 4);
                    f32x4 y0, y1; unpack8(*(const u32x4*)(Y + off + bj * HALF), y0, y1);
                    f32x4 o0, o1;
#pragma unroll
                    for (int j = 0; j < 4; ++j) { o0[j] = y0[j] * fsigmoid(acc[ai][bj][m][0][j] + b0[j]); o1[j] = y1[j] * fsigmoid(acc[ai][bj][m][1][j] + b1[j]); }
                    *(u32x4*)(O + off + bj * HALF) = pack8(o0, o1); } }
    }
};
struct EpiPle {
    static constexpr bool PERM = true, AFTER_DRAIN = false;
    bf16_t* F;
    __device__ __forceinline__ void operator()(const AccT& acc, const Unit& u, int wr, int wc, int fr, int fq) const {
        const int row0 = u.pm * BM + wr * 64 + fr, col0 = u.pn * BM + wc * 32 + 8 * fq;
#pragma unroll
        for (int ai = 0; ai < 2; ++ai)
#pragma unroll
            for (int m = 0; m < 4; ++m) { const size_t off = (size_t)(row0 + ai * HALF + m * 16) * DM + col0;
#pragma unroll
                for (int bj = 0; bj < 2; ++bj) { f32x4 y0, y1; unpack8(*(const u32x4*)(F + off + bj * HALF), y0, y1);
                    f32x4 o0, o1;
#pragma unroll
                    for (int j = 0; j < 4; ++j) { o0[j] = y0[j] * fsigmoid(acc[ai][bj][m][0][j]); o1[j] = y1[j] * fsigmoid(acc[ai][bj][m][1][j]); }
                    *(u32x4*)(F + off + bj * HALF) = pack8(o0, o1); } }
    }
};

struct RowExch {
    unsigned long long* xbuf; unsigned tag;
    __device__ __forceinline__ void run(const float (&part)[2][4], int panel, int pn, int wr, int wc, int fr, int fq, LAS unsigned char* lds, int wid, int lane) const {
        LAS float* P = (LAS float*)(lds + LDS_TAB);
        LAS float* S = (LAS float*)(lds + LDS_TAB + 4096);
#pragma unroll
        for (int ai = 0; ai < 2; ++ai)
#pragma unroll
            for (int m = 0; m < 4; ++m) { float sv = part[ai][m]; sv += shx(sv, 16, lane); sv += shx(sv, 32, lane);
                if (fq == 0) P[(ai * HALF + wr * 64 + m * 16 + fr) * 4 + wc] = sv; }
        asm volatile("s_waitcnt lgkmcnt(0)" ::: "memory"); __builtin_amdgcn_s_barrier(); asm volatile("" ::: "memory");
        if (lane < 32) { const int row = wid * 32 + lane; const f32x4 p = *(const LAS f32x4*)(P + row * 4);
            unsigned long long* slot = xbuf + ((size_t)panel * 256 + row) * 4;
            __hip_atomic_store(slot + pn, ((unsigned long long)tag << 32) | (unsigned long long)__float_as_uint((p[0] + p[1]) + (p[2] + p[3])), __ATOMIC_RELAXED, __HIP_MEMORY_SCOPE_AGENT);
            float t = 0.f;
            for (unsigned spin = 0; spin < 200000u; ++spin) {
                const unsigned long long g0 = __hip_atomic_load(slot + 0, __ATOMIC_RELAXED, __HIP_MEMORY_SCOPE_AGENT), g1 = __hip_atomic_load(slot + 1, __ATOMIC_RELAXED, __HIP_MEMORY_SCOPE_AGENT),
                                         g2 = __hip_atomic_load(slot + 2, __ATOMIC_RELAXED, __HIP_MEMORY_SCOPE_AGENT), g3 = __hip_atomic_load(slot + 3, __ATOMIC_RELAXED, __HIP_MEMORY_SCOPE_AGENT);
                t = (__uint_as_float((unsigned)g0) + __uint_as_float((unsigned)g1)) + (__uint_as_float((unsigned)g2) + __uint_as_float((unsigned)g3));
                if ((unsigned)(g0 >> 32) == tag && (unsigned)(g1 >> 32) == tag && (unsigned)(g2 >> 32) == tag && (unsigned)(g3 >> 32) == tag) break;
                __builtin_amdgcn_s_sleep(1); }
            S[row] = t; }
        asm volatile("s_waitcnt vmcnt(0) lgkmcnt(0)" ::: "memory"); __builtin_amdgcn_s_barrier(); asm volatile("" ::: "memory");
    }
};
struct EpiFuse {
    static constexpr bool PERM = true, AFTER_DRAIN = false;
    LAS unsigned char* lds;
    __device__ __forceinline__ void operator()(const AccT& acc_, const Unit& u, int wr, int wc, int fr, int fq) const { fused(const_cast<AccT&>(acc_), u, wr, wc, fr, fq, lds, wr * 4 + wc, fq * 16 + fr); }
    int row_base; bf16_t* H; float* OUTF; float* RS; const bf16_t* UP; const float* gpost; float scale; int xmode;
    unsigned char* xw; unsigned tg1, tg2;
    __device__ __forceinline__ void fused(AccT& acc, const Unit& u, int wr, int wc, int fr, int fq, LAS unsigned char* lds, int wid, int lane) const {
        const int col0 = u.pn * BM + wc * 32 + 8 * fq, panel = (row_base >> 8) + u.pm;
        const int rloc0 = wr * 64 + fr; const size_t grow0 = (size_t)row_base + (size_t)u.pm * BM + rloc0;
        if (UP) {
#pragma unroll
            for (int ai = 0; ai < 2; ++ai)
#pragma unroll
                for (int m = 0; m < 4; ++m)
#pragma unroll
                    for (int bj = 0; bj < 2; ++bj) { f32x4 y0, y1; unpack8(*(const u32x4*)(UP + (grow0 + ai * HALF + m * 16) * DM + col0 + bj * HALF), y0, y1);
#pragma unroll
                        for (int j = 0; j < 4; ++j) { acc[ai][bj][m][0][j] = y0[j] * fsigmoid(acc[ai][bj][m][0][j]); acc[ai][bj][m][1][j] = y1[j] * fsigmoid(acc[ai][bj][m][1][j]); }
                        if (bj == 1 && (m & 1)) { asm volatile("" : "+v"(acc[ai][0][m][0]), "+v"(acc[ai][0][m][1]), "+v"(acc[ai][1][m][0]), "+v"(acc[ai][1][m][1]), "+v"(acc[ai][0][m - 1][0]), "+v"(acc[ai][0][m - 1][1]), "+v"(acc[ai][1][m - 1][0]), "+v"(acc[ai][1][m - 1][1])); asm volatile("" ::: "memory"); } }
        }
        float part[2][4];
#pragma unroll
        for (int ai = 0; ai < 2; ++ai)
#pragma unroll
            for (int m = 0; m < 4; ++m) { float sv = 0.f;
#pragma unroll
                for (int bj = 0; bj < 2; ++bj)
#pragma unroll
                    for (int n = 0; n < 2; ++n) { const f32x4 x = acc[ai][bj][m][n]; sv += (x[0] * x[0] + x[1] * x[1]) + (x[2] * x[2] + x[3] * x[3]); }
                part[ai][m] = sv; }
        asm volatile("" ::: "memory");
        size_t growh = grow0; asm volatile("" : "+v"(growh));
        u32x4 hr[4][2];
#pragma unroll
        for (int q = 0; q < 4; ++q)
#pragma unroll
            for (int bj = 0; bj < 2; ++bj) hr[q][bj] = *(const u32x4*)(H + (growh + q * 16) * DM + col0 + bj * HALF);
        f32x4 gp[2][2];
#pragma unroll
        for (int bj = 0; bj < 2; ++bj) { gp[bj][0] = *(const f32x4*)(gpost + col0 + bj * HALF); gp[bj][1] = *(const f32x4*)(gpost + col0 + bj * HALF + 4); }
        { const RowExch e1{(unsigned long long*)(xw + X_B1), tg1}; e1.run(part, panel, u.pn, wr, wc, fr, fq, lds, wid, lane); }
        const LAS float* S = (const LAS float*)(lds + LDS_TAB + 4096);
#pragma unroll
        for (int rg = 0; rg < 8; ++rg) { const int ai = rg >> 2, m = rg & 3, q = rg & 3;
            const int rl = rloc0 + ai * HALF + m * 16; const float rs = scale / sqrtf(S[rl] * (1.0f / DM) + EPS);
            bf16_t* hp = H + (growh + ai * HALF + m * 16) * DM + col0; float sv = 0.f;
#pragma unroll
            for (int bj = 0; bj < 2; ++bj) { f32x4 r0, r1; unpack8(hr[q][bj], r0, r1);
                const f32x4 h0 = r0 + acc[ai][bj][m][0] * gp[bj][0] * rs, h1 = r1 + acc[ai][bj][m][1] * gp[bj][1] * rs;
                *(u32x4*)(hp + bj * HALF) = pack8(h0, h1);
                if (OUTF) { float* op = OUTF + (growh + ai * HALF + m * 16) * DM + col0 + bj * HALF; *(f32x4*)op = h0; *(f32x4*)(op + 4) = h1; }
                acc[ai][bj][m][0] = h0; acc[ai][bj][m][1] = h1;
                sv += (h0[0] * h0[0] + h0[1] * h0[1]) + (h0[2] * h0[2] + h0[3] * h0[3]) + (h1[0] * h1[0] + h1[1] * h1[1]) + (h1[2] * h1[2] + h1[3] * h1[3]);
                if (rg + 4 < 8) hr[q][bj] = *(const u32x4*)(H + (growh + HALF + m * 16) * DM + col0 + bj * HALF); }
            part[ai][m] = sv;
            if (m == 3) asm volatile("" ::: "memory"); }
        if (xmode == 1) {
            size_t growx = grow0; asm volatile("" : "+v"(growx));
#pragma unroll
            for (int ai = 0; ai < 2; ++ai)
#pragma unroll
                for (int m = 0; m < 4; ++m) { float sv = part[ai][m]; sv += shx(sv, 16, lane); sv += shx(sv, 32, lane);
                    if (fq == 0) RS[(growx + ai * HALF + m * 16) * 16 + u.pn * 4 + wc] = sv; }
        }
    }
};

template <class Epi, class Sched, bool ALIGN_EPI = false, bool SP2 = false>
__device__ __forceinline__ void gemm_phase(PG8_LAS unsigned char* lds, const Gemm g, const Sched& S, const Epi& E, const int wv) {
    const int tid = opaque_tid(wv), wid = __builtin_amdgcn_readfirstlane(tid >> 6), lane = tid & 63, wr = wid >> 2, wc = wid & 3, fr = lane & 15, fq = lane >> 4;
    const int K = g.K, nt = K / BK;
    unsigned voffA[2], voffB[2];
#pragma unroll
    for (int i = 0; i < 2; ++i) { int R, C; stage_rc(tid * 16 + i * 8192, R, C); const int Rb = Epi::PERM ? ((R & ~31) + perm32(R & 31)) : R;
        voffA[i] = (unsigned)(R * g.lda + C) * 2u; voffB[i] = (unsigned)(Rb * g.ldb + C) * 2u; }
    const size_t kstep = (size_t)(BK * 2);
    const size_t hstepA = (size_t)HALF * g.lda * 2, hstepB = (size_t)HALF * g.ldb * 2;
    const size_t tstepA = 2 * hstepA, tstepB = 2 * hstepB;
    const unsigned ldsw = (unsigned)wid * 1024u;
    const int aoff = lds_byte(wr * 64 + fr, fq * 8), boff = lds_byte(wc * 32 + fr, fq * 8);
#define PG8_SA(b, h) (((b) * 2 + (h)) * HTB)
#define PG8_SB(b, h) ((4 + (b) * 2 + (h)) * HTB)
#define PG8_STAGE(bufoff, gbase, voff) do { _Pragma("unroll") for (int _i = 0; _i < 2; ++_i) \
        __builtin_amdgcn_global_load_lds((const unsigned*)((const char*)(gbase) + (voff)[_i]), (PG8_LAS unsigned*)(lds + (bufoff) + ldsw + _i * 8192), 16, 0, 0); } while (0)
#define PG8_LDA(dst, b, h) do { _Pragma("unroll") for (int m = 0; m < 4; ++m) _Pragma("unroll") for (int k = 0; k < 2; ++k) dst[m][k] = *(const PG8_LAS bf16x8*)(lds + PG8_SA(b, h) + aoff + m * 2048 + k * 1024); } while (0)
#define PG8_LDB(dst, b, h) do { _Pragma("unroll") for (int n = 0; n < 2; ++n) _Pragma("unroll") for (int k = 0; k < 2; ++k) dst[n][k] = *(const PG8_LAS bf16x8*)(lds + PG8_SB(b, h) + boff + n * 2048 + k * 1024); } while (0)
#define PG8_MMA(ai, bj, At, Bt) do { __builtin_amdgcn_s_setprio(1); _Pragma("unroll") for (int m = 0; m < 4; ++m) _Pragma("unroll") for (int n = 0; n < 2; ++n) _Pragma("unroll") for (int k = 0; k < 2; ++k) \
        acc[ai][bj][m][n] = __builtin_amdgcn_mfma_f32_16x16x32_bf16(Bt[n][k], At[m][k], acc[ai][bj][m][n], 0, 0, 0); __builtin_amdgcn_s_setprio(0); } while (0)
#define PG8_WAIT_V(n) asm volatile("s_waitcnt vmcnt(" #n ")" ::: "memory")
#define PG8_WAIT_L(n) asm volatile("s_waitcnt lgkmcnt(" #n ")" ::: "memory")
#define PG8_BAR __builtin_amdgcn_s_barrier()
#define PG8_SCHED __builtin_amdgcn_sched_barrier(0)
    Unit cur, nxt; int ui = 0;
    if (!S.next(0, cur)) return;
    f32x4 acc[2][2][4][2];
#pragma unroll
    for (int a = 0; a < 2; ++a)
#pragma unroll
        for (int b = 0; b < 2; ++b)
#pragma unroll
            for (int m = 0; m < 4; ++m)
#pragma unroll
                for (int n = 0; n < 2; ++n) acc[a][b][m][n] = (f32x4){0.f, 0.f, 0.f, 0.f};
    bf16x8 At[4][2], B0[2][2], B1[2][2];
    const char* cA = (const char*)g.A + (size_t)cur.z * g.zA + (size_t)cur.pm * tstepA; const char* cB = (const char*)g.Bt + (size_t)cur.z * g.zB + (size_t)cur.pn * tstepB;
    S.a_ready(cur);
    if constexpr (SP2) {
        PG8_STAGE(PG8_SB(0, 0), cB, voffB); PG8_STAGE(PG8_SB(0, 1), cB + hstepB, voffB); PG8_STAGE(PG8_SA(0, 0), cA, voffA); PG8_STAGE(PG8_SA(0, 1), cA + hstepA, voffA);
        if (wr == 1) PG8_BAR;
        PG8_WAIT_V(2); PG8_BAR;
        PG8_STAGE(PG8_SB(1, 0), cB + kstep, voffB); PG8_STAGE(PG8_SA(1, 0), cA + kstep, voffA); PG8_STAGE(PG8_SB(1, 1), cB + hstepB + kstep, voffB);
        PG8_WAIT_V(6); PG8_BAR;
    } else {
        PG8_STAGE(PG8_SB(0, 0), cB, voffB); PG8_STAGE(PG8_SA(0, 0), cA, voffA); PG8_STAGE(PG8_SB(0, 1), cB + hstepB, voffB); PG8_STAGE(PG8_SA(0, 1), cA + hstepA, voffA);
        if (wr == 1) PG8_BAR;
        PG8_WAIT_V(4); PG8_BAR;
        PG8_STAGE(PG8_SB(1, 0), cB + kstep, voffB); PG8_STAGE(PG8_SA(1, 0), cA + kstep, voffA); PG8_STAGE(PG8_SB(1, 1), cB + hstepB + kstep, voffB);
        PG8_WAIT_V(6); PG8_BAR;
    }
    for (;;) {
        const bool has_next = S.next(ui + 1, nxt);
        const char* nA = has_next ? (const char*)g.A + (size_t)nxt.z * g.zA + (size_t)nxt.pm * tstepA : cA; const char* nB = has_next ? (const char*)g.Bt + (size_t)nxt.z * g.zB + (size_t)nxt.pn * tstepB : cB;
        for (int t = 0; t < nt; t += 2) {
            const bool last = (t == nt - 2);
            const char* a1 = cA + (size_t)(t + 1) * kstep;
            const char* a2 = last ? nA : cA + (size_t)(t + 2) * kstep; const char* b2 = last ? nB : cB + (size_t)(t + 2) * kstep;
            const char* a3 = a2 + kstep; const char* b3 = b2 + kstep;
            if (last && has_next) S.a_ready(nxt);
            if constexpr (SP2) {
            PG8_LDB(B0, 0, 0); PG8_LDB(B1, 0, 1); PG8_SCHED; PG8_LDA(At, 0, 0); PG8_STAGE(PG8_SA(1, 1), a1 + hstepA, voffA);
            PG8_WAIT_V(8); PG8_WAIT_L(0); PG8_BAR; PG8_MMA(0, 0, At, B0); PG8_MMA(0, 1, At, B1); PG8_BAR; PG8_SCHED;
            PG8_LDA(At, 0, 1); PG8_STAGE(PG8_SB(0, 0), b2, voffB); PG8_STAGE(PG8_SB(0, 1), b2 + hstepB, voffB); PG8_STAGE(PG8_SA(0, 0), a2, voffA);
            PG8_WAIT_V(8); PG8_WAIT_L(0); PG8_BAR; PG8_MMA(1, 0, At, B0); PG8_MMA(1, 1, At, B1); PG8_BAR; PG8_SCHED;
            PG8_LDB(B0, 1, 0); PG8_LDB(B1, 1, 1); PG8_SCHED; PG8_LDA(At, 1, 0); PG8_STAGE(PG8_SA(0, 1), a2 + hstepA, voffA);
            PG8_WAIT_V(8); PG8_WAIT_L(0); PG8_BAR; PG8_MMA(0, 0, At, B0); PG8_MMA(0, 1, At, B1); PG8_BAR; PG8_SCHED;
            PG8_LDA(At, 1, 1); PG8_STAGE(PG8_SB(1, 0), b3, voffB); PG8_STAGE(PG8_SB(1, 1), b3 + hstepB, voffB); PG8_STAGE(PG8_SA(1, 0), a3, voffA);
            PG8_WAIT_V(8); PG8_WAIT_L(0); PG8_BAR; PG8_MMA(1, 0, At, B0); PG8_MMA(1, 1, At, B1); PG8_BAR; PG8_SCHED;
            } else {
            PG8_LDB(B0, 0, 0); PG8_SCHED; PG8_LDA(At, 0, 0); PG8_STAGE(PG8_SA(1, 1), a1 + hstepA, voffA);
            PG8_WAIT_L(8); PG8_BAR; PG8_WAIT_L(0); PG8_MMA(0, 0, At, B0); PG8_BAR; PG8_SCHED;
            PG8_LDB(B1, 0, 1); PG8_STAGE(PG8_SB(0, 0), b2, voffB);
            PG8_BAR; PG8_WAIT_L(0); PG8_MMA(0, 1, At, B1); PG8_BAR;
            PG8_LDA(At, 0, 1); PG8_STAGE(PG8_SA(0, 0), a2, voffA);
            PG8_BAR; PG8_WAIT_L(0); PG8_MMA(1, 0, At, B0); PG8_BAR; PG8_SCHED;
            PG8_STAGE(PG8_SB(0, 1), b2 + hstepB, voffB);
            PG8_WAIT_V(6); PG8_BAR; PG8_MMA(1, 1, At, B1); PG8_BAR;
            PG8_LDB(B0, 1, 0); PG8_SCHED; PG8_LDA(At, 1, 0); PG8_STAGE(PG8_SA(0, 1), a2 + hstepA, voffA);
            PG8_WAIT_L(8); PG8_BAR; PG8_WAIT_L(0); PG8_MMA(0, 0, At, B0); PG8_BAR; PG8_SCHED;
            PG8_LDB(B1, 1, 1); PG8_STAGE(PG8_SB(1, 0), b3, voffB);
            PG8_BAR; PG8_WAIT_L(0); PG8_MMA(0, 1, At, B1); PG8_BAR;
            PG8_LDA(At, 1, 1); PG8_STAGE(PG8_SA(1, 0), a3, voffA);
            PG8_BAR; PG8_WAIT_L(0); PG8_MMA(1, 0, At, B0); PG8_BAR; PG8_SCHED;
            PG8_STAGE(PG8_SB(1, 1), b3 + hstepB, voffB);
            PG8_WAIT_V(6); PG8_BAR; PG8_MMA(1, 1, At, B1); PG8_BAR;
            }
        }
        if constexpr (ALIGN_EPI) { if (wr == 0) PG8_BAR; }
        if constexpr (!Epi::AFTER_DRAIN) { const int t2 = opaque_tid(wv), w2 = __builtin_amdgcn_readfirstlane(t2 >> 6), l2 = t2 & 63; E(acc, cur, w2 >> 2, w2 & 3, l2 & 15, l2 >> 4); S.done(cur); }
        if (!has_next) break;
#pragma unroll
        for (int a = 0; a < 2; ++a)
#pragma unroll
            for (int b = 0; b < 2; ++b)
#pragma unroll
                for (int m = 0; m < 4; ++m)
#pragma unroll
                    for (int n = 0; n < 2; ++n) acc[a][b][m][n] = (f32x4){0.f, 0.f, 0.f, 0.f};
        cur = nxt; cA = nA; cB = nB; ++ui;
        if constexpr (ALIGN_EPI) { if (wr == 1) PG8_BAR; }
    }
    PG8_WAIT_V(0);
    if constexpr (!ALIGN_EPI) { if (wr == 0) PG8_BAR; }
    PG8_BAR;
    if constexpr (Epi::AFTER_DRAIN) { const int t2 = opaque_tid(wv), w2 = __builtin_amdgcn_readfirstlane(t2 >> 6), l2 = t2 & 63; E.fused(acc, cur, w2 >> 2, w2 & 3, l2 & 15, l2 >> 4, lds, w2, l2); S.done(cur); }
#undef PG8_SA
#undef PG8_SB
#undef PG8_STAGE
#undef PG8_LDA
#undef PG8_LDB
#undef PG8_MMA
#undef PG8_WAIT_V
#undef PG8_WAIT_L
#undef PG8_BAR
#undef PG8_SCHED
}

__device__ __forceinline__ void transpose_item(const float* W, const float* gk, int K, int N, bf16_t* WT, int kb, int n0, int orow0, LAS float* scr, int lane) {
    const int k0 = 64 * kb;
    float v[32];
    const float* wp = W + (size_t)(k0 + (lane >> 5)) * N + n0 + (lane & 31);
#pragma unroll
    for (int i = 0; i < 32; ++i) v[i] = wp[(size_t)(2 * i) * N];
    if (gk) {
#pragma unroll
        for (int i = 0; i < 32; ++i) v[i] *= gk[k0 + 2 * i + (lane >> 5)]; }
#pragma unroll
    for (int i = 0; i < 32; ++i) scr[(2 * i + (lane >> 5)) * 33 + (lane & 31)] = v[i];
    LDS_FENCE();
    const int c = lane & 7;
#pragma unroll
    for (int j = 0; j < 4; ++j) { const int n = (lane >> 3) + 8 * j; const LAS float* s = scr + (8 * c) * 33 + n;
        u32x4 o; o.x = cvt_pk_bf16(s[0 * 33], s[1 * 33]); o.y = cvt_pk_bf16(s[2 * 33], s[3 * 33]); o.z = cvt_pk_bf16(s[4 * 33], s[5 * 33]); o.w = cvt_pk_bf16(s[6 * 33], s[7 * 33]);
        *(u32x4*)(WT + (size_t)(orow0 + n) * K + k0 + 8 * c) = o; }
    LDS_FENCE();
}

__device__ __forceinline__ void build_ssm_mats(int g, int qt, const float* lam_re, const float* lam_im, const float* log_dt, const float* b_re, const float* b_im,
                                               const float* c_re, const float* c_im, const float* dsk, bf16_t* Tt, bf16_t* W1t, LAS unsigned char* lds, int tid) {
    LAS f32x2* pwt = (LAS f32x2*)lds;
    LAS f32x2* bb = (LAS f32x2*)(lds + 16896);
    LAS f32x2* cct = (LAS f32x2*)(lds + 16896 + 8192);
    LAS float* Km = (LAS float*)(lds + 16896 + 16384);
    const float dt = expf(log_dt[g]);
    for (int idx = tid; idx < 64 * 33; idx += NTHREADS) { const int p = idx / 33, d = idx % 33;
        const float re = lam_re[g * 64 + p] * dt * (float)d, im = lam_im[g * 64 + p] * dt * (float)d; const float e = expf(re);
        pwt[idx] = (f32x2){e * cosf(im), e * sinf(im)}; }
    for (int idx = tid; idx < 1024; idx += NTHREADS) { const int p = idx >> 4, hh = idx & 15;
        const float lr = lam_re[g * 64 + p], li = lam_im[g * 64 + p]; const float e = expf(lr * dt);
        const float nr = e * cosf(li * dt) - 1.0f, ni = e * sinf(li * dt), den = 1.0f / (lr * lr + li * li);
        const float kr = (nr * lr + ni * li) * den, ki = (ni * lr - nr * li) * den;
        const float br = b_re[(g * 64 + p) * 16 + hh], bi = b_im[(g * 64 + p) * 16 + hh];
        bb[idx] = (f32x2){kr * br - ki * bi, kr * bi + ki * br};
        cct[idx] = (f32x2){c_re[(g * 16 + hh) * 64 + p], c_im[(g * 16 + hh) * 64 + p]}; }
    __syncthreads();
    { const int d = tid >> 4, hh = tid & 15;
      float a0 = 0.f, a1 = 0.f, a2 = 0.f, a3 = 0.f, a4 = 0.f, a5 = 0.f, a6 = 0.f, a7 = 0.f, a8 = 0.f, a9 = 0.f, a10 = 0.f, a11 = 0.f, a12 = 0.f, a13 = 0.f, a14 = 0.f, a15 = 0.f;
      for (int p = 0; p < 64; ++p) { const f32x2 c = cct[p * 16 + hh], w = pwt[p * 33 + d]; const float wr_ = c.x * w.x - c.y * w.y, wi_ = c.x * w.y + c.y * w.x;
          const LAS f32x2* bp = bb + p * 16;
#define KACC(i, a) { const f32x2 b = bp[i]; a += wr_ * b.x - wi_ * b.y; }
          KACC(0, a0) KACC(1, a1) KACC(2, a2) KACC(3, a3) KACC(4, a4) KACC(5, a5) KACC(6, a6) KACC(7, a7) KACC(8, a8) KACC(9, a9) KACC(10, a10) KACC(11, a11) KACC(12, a12) KACC(13, a13) KACC(14, a14) KACC(15, a15)
#undef KACC
      }
      LAS float* kp = Km + (d * 16 + hh) * 16;
      kp[0] = a0; kp[1] = a1; kp[2] = a2; kp[3] = a3; kp[4] = a4; kp[5] = a5; kp[6] = a6; kp[7] = a7; kp[8] = a8; kp[9] = a9; kp[10] = a10; kp[11] = a11; kp[12] = a12; kp[13] = a13; kp[14] = a14; kp[15] = a15; }
    __syncthreads();
    bf16_t* Tg = Tt + (size_t)g * 512 * KT;
    for (int ch = tid; ch < 128 * 80; ch += NTHREADS) { const int n = qt * 128 + ch / 80, c8 = ch % 80, tau = n >> 4, hh = n & 15, col = c8 * 8;
        f32x4 v0, v1;
        if (col < 512) { const int sig = col >> 4, h0 = col & 15;
#pragma unroll
            for (int e = 0; e < 8; ++e) { const int h2 = h0 + e; float x = (sig <= tau) ? Km[((tau - sig) * 16 + hh) * 16 + h2] : 0.f; if (sig == tau && h2 == hh) x += dsk[g * 16 + hh];
                if (e < 4) v0[e] = x; else v1[e - 4] = x; }
        } else { const int part = (col - 512) >> 6, p0 = (col - 512) & 63;
#pragma unroll
            for (int e = 0; e < 8; ++e) { const int p = p0 + e; const f32x2 c = cct[p * 16 + hh], w = pwt[p * 33 + tau + 1];
                const float x = part == 0 ? (c.x * w.x - c.y * w.y) : -(c.x * w.y + c.y * w.x);
                if (e < 4) v0[e] = x; else v1[e - 4] = x; } }
        *(u32x4*)(Tg + (size_t)n * KT + col) = pack8(v0, v1); }
    bf16_t* Wg = W1t + (size_t)g * 256 * 512;
    for (int ch = tid; ch < 64 * 64; ch += NTHREADS) { const int n = qt * 64 + (ch >> 6), c8 = ch & 63, col = c8 * 8, sig = col >> 4, h0 = col & 15;
        f32x4 v0 = (f32x4){0.f, 0.f, 0.f, 0.f}, v1 = v0;
        if (n < 128) { const int p = n & 63, part = n >> 6; const f32x2 w = pwt[p * 33 + 31 - sig];
#pragma unroll
            for (int e = 0; e < 8; ++e) { const f32x2 b = bb[p * 16 + h0 + e]; const float x = part == 0 ? (w.x * b.x - w.y * b.y) : (w.x * b.y + w.y * b.x);
                if (e < 4) v0[e] = x; else v1[e - 4] = x; } }
        *(u32x4*)(Wg + (size_t)n * 512 + col) = pack8(v0, v1); }
    __syncthreads();
}

__device__ int MAT_TAB[12][7] = {
    {4, 1024, 2816, (int)W_GU1, 1, 0, 3}, {5, 1024, 2816, (int)W_GU1, 2, 1408, 3}, {6, 2816, 1024, (int)W_D1, 0, 2816, -1},
    {25, 1024, 2816, (int)W_GU2, 1, 4224, 24}, {26, 1024, 2816, (int)W_GU2, 2, 5632, 24}, {27, 2816, 1024, (int)W_D2, 0, 7040, -1},
    {9, 1024, 2048, (int)W_IN, 0, 8448, 8}, {19, 512, 512, (int)W_GLU, 0, 9472, -1}, {22, 1024, 1024, (int)W_OUT, 0, 9600, -1}, {30, 1024, 1024, (int)W_PG, 0, 10112, -1},
    {29, 256, 1024, (int)W_PUP, 0, 10624, -1}, {0, 0, 0, 0, 0, 10752, -1}};
template <bool ROT> __device__ __forceinline__ void prep_layer(KA ka, int l, LAS unsigned char* lds, const int wv) {
    const int tid = opaque_tid(wv), wave = __builtin_amdgcn_readfirstlane(tid >> 6), lane = tid & 63; (void)tid; (void)wave; (void)lane;
    unsigned char* ws = kws(ka); unsigned char* wb = ws + WS_W;
    const int G = gridDim.x;
    for (int gq = blockIdx.x; gq < NGRP * 4; gq += G)
        build_ssm_mats(gq >> 2, gq & 3, kin(ka, 11) + l * 2048, kin(ka, 12) + l * 2048, kin(ka, 13) + l * 32, kin(ka, 14) + (size_t)l * 32768, kin(ka, 15) + (size_t)l * 32768, kin(ka, 16) + (size_t)l * 32768,
                       kin(ka, 17) + (size_t)l * 32768, kin(ka, 18) + l * 512, (bf16_t*)(wb + W_T), (bf16_t*)(wb + W_W1), lds, tid);
    LAS float* scr = (LAS float*)(lds + wave * 8448);
    const int gw = blockIdx.x * 8 + wave, NGW = G * 8;
    for (int it = gw; it < 10752; it += NGW) {
        int itv = it; asm volatile("" : "+s"(itv));
        const int m = (itv >= 1408) + (itv >= 2816) + (itv >= 4224) + (itv >= 5632) + (itv >= 7040) + (itv >= 8448) + (itv >= 9472) + (itv >= 9600) + (itv >= 10112) + (itv >= 10624);
        const int in_idx = MAT_TAB[m][0], K = MAT_TAB[m][1], N = MAT_TAB[m][2], woff = MAT_TAB[m][3], mode = MAT_TAB[m][4], r = it - MAT_TAB[m][5]; const int gi = MAT_TAB[m][6];
        const int nb = N >> 5, kb = r / nb, n0 = 32 * (r % nb);
        const int orow0 = mode ? (n0 >> 7) * 256 + (mode - 1) * 128 + (n0 & 127) : n0;
        transpose_item(kin(ka, in_idx) + (size_t)l * K * N, gi >= 0 ? kin(ka, gi) + l * DM : nullptr, K, N, (bf16_t*)(wb + woff), kb, n0, orow0, scr, lane);
    }
    { const f32x4* src = (const f32x4*)(kin(ka, 1) + (size_t)l * MT * PLE); u32x4* dst = (u32x4*)(ws + WS_PB);
      const int nth = G * NTHREADS;
      for (int i0 = blockIdx.x * NTHREADS + tid; i0 < MT * PLE / 8; i0 += 4 * nth) {
          f32x4 t[4][2];
#pragma unroll
          for (int q = 0; q < 4; ++q) { const int i = i0 + q * nth; if (i < MT * PLE / 8) { t[q][0] = src[2 * i]; t[q][1] = src[2 * i + 1]; } }
#pragma unroll
          for (int q = 0; q < 4; ++q) { const int i = i0 + q * nth; if (i < MT * PLE / 8) dst[i] = pack8(t[q][0], t[q][1]); } } }
    if constexpr (ROT) {
        const int* pos = (const int*)kin(ka, 2); f32x2* rot = (f32x2*)(ws + WS_ROT);
        const int nth = G * NTHREADS;
        for (int i = blockIdx.x * NTHREADS + tid; i < MT * 8; i += nth) { const int k = i & 7;
            const double f = k == 0 ? 1.0 : k == 1 ? 0.19392274474868576 : k == 2 ? 0.03760603093086393 : k == 3 ? 0.007292664737217109 : k == 4 ? 0.001414213562373095 :
                             k == 5 ? 0.0002742481756762073 : k == 6 ? 5.318295896944988e-05 : 1.031338537721246e-05;
            const double ang = (double)pos[i >> 3] * f; const double kk = rint(ang * 0.15915494309189535); const float rr = (float)(ang - kk * 6.283185307179586);
            rot[i] = (f32x2){cosf(rr), sinf(rr)}; }
    }
}

__device__ __forceinline__ void row_phase(const float* hin, bf16_t* hb, float* rs16, const int wv) {
    const int tid = opaque_tid(wv), wave = __builtin_amdgcn_readfirstlane(tid >> 6), lane = tid & 63; (void)tid;
    const int gw = blockIdx.x * 8 + wave, NGW = gridDim.x * 8;
    for (int row = gw; row < MT; row += NGW) {
        const f32x4* hp = (const f32x4*)(hin + (size_t)row * DM) + lane;
        f32x4 v[4]; float ss = 0.f;
#pragma unroll
        for (int j = 0; j < 4; ++j) { v[j] = hp[64 * j]; ss += (v[j][0] * v[j][0] + v[j][1] * v[j][1]) + (v[j][2] * v[j][2] + v[j][3] * v[j][3]); }
        ss = wave_sum(ss, lane);
        u32x2* bp = (u32x2*)(hb + (size_t)row * DM) + lane;
#pragma unroll
        for (int j = 0; j < 4; ++j) { u32x2 w; w.x = cvt_pk_bf16(v[j][0], v[j][1]); w.y = cvt_pk_bf16(v[j][2], v[j][3]); bp[64 * j] = w; }
        if (lane < 16) rs16[(size_t)row * 16 + lane] = lane == 0 ? ss : 0.f;
    }
}

__device__ __forceinline__ void mix_rows(const bf16_t* ao, const float* lse, const bf16_t* ssmo, const float* g_attn, const float* g_ssm, bf16_t* xn, const int wv) {
    const int tid = opaque_tid(wv), wave = __builtin_amdgcn_readfirstlane(tid >> 6), lane = tid & 63; (void)tid; (void)wave; (void)lane;
    const int gw = blockIdx.x * 8 + wave, NGW = gridDim.x * 8;
    const int h = lane >> 3;
    const f32x4 ga0 = ((const f32x4*)g_attn)[2 * lane], ga1 = ((const f32x4*)g_attn)[2 * lane + 1], gs0 = ((const f32x4*)g_ssm)[2 * lane], gs1 = ((const f32x4*)g_ssm)[2 * lane + 1];
    for (int row0 = gw; row0 < MT; row0 += 4 * NGW) {
        u32x4 va[4][3], vs[4]; float ll[4][3];
#pragma unroll
        for (int q = 0; q < 4; ++q) { const int row = row0 + q * NGW; if (row < MT) {
#pragma unroll
            for (int p = 0; p < 3; ++p) { va[q][p] = *(const u32x4*)(ao + ((size_t)p * MT + row) * DATT + 8 * lane); ll[q][p] = lse[((size_t)p * MT + row) * 8 + h]; }
            vs[q] = *(const u32x4*)(ssmo + (size_t)row * DSSM + 8 * lane); } }
#pragma unroll
        for (int q = 0; q < 4; ++q) { const int row = row0 + q * NGW; if (row < MT) {
            const float mx = fmaxf(ll[q][0], fmaxf(ll[q][1], ll[q][2]));
            float w0 = __builtin_amdgcn_exp2f(ll[q][0] - mx), w1 = __builtin_amdgcn_exp2f(ll[q][1] - mx), w2 = __builtin_amdgcn_exp2f(ll[q][2] - mx); const float inv = 1.0f / (w0 + w1 + w2); w0 *= inv; w1 *= inv; w2 *= inv;
            f32x4 a0, a1, b0, b1;
            unpack8(va[q][0], a0, a1); a0 *= w0; a1 *= w0;
            unpack8(va[q][1], b0, b1); a0 += b0 * w1; a1 += b1 * w1;
            unpack8(va[q][2], b0, b1); a0 += b0 * w2; a1 += b1 * w2;
            float ss = (a0[0] * a0[0] + a0[1] * a0[1]) + (a0[2] * a0[2] + a0[3] * a0[3]) + (a1[0] * a1[0] + a1[1] * a1[1]) + (a1[2] * a1[2] + a1[3] * a1[3]);
            float rs = 1.0f / sqrtf(wave_sum(ss, lane) * (1.0f / DATT) + EPS);
            *(u32x4*)(xn + (size_t)row * DM + 8 * lane) = pack8(a0 * rs * ga0, a1 * rs * ga1);
            unpack8(vs[q], b0, b1);
            ss = (b0[0] * b0[0] + b0[1] * b0[1]) + (b0[2] * b0[2] + b0[3] * b0[3]) + (b1[0] * b1[0] + b1[1] * b1[1]) + (b1[2] * b1[2] + b1[3] * b1[3]);
            rs = 1.0f / sqrtf(wave_sum(ss, lane) * (1.0f / DSSM) + EPS);
            *(u32x4*)(xn + (size_t)row * DM + DATT + 8 * lane) = pack8(b0 * rs * gs0, b1 * rs * gs1); } }
    }
}

__device__ __forceinline__ void scan_own(int g, int pm, const float* lam_re, const float* lam_im, const float* log_dt, const float* sloc, bf16_t* Ap, LAS unsigned char* lds, const int wv) {
    const int tid = opaque_tid(wv), wave = __builtin_amdgcn_readfirstlane(tid >> 6), lane = tid & 63; (void)tid;
    LAS f32x2* E = (LAS f32x2*)lds;
    const int p = lane;
    asm volatile("s_waitcnt vmcnt(0)" ::: "memory"); __syncthreads();
    const float dt = expf(log_dt[g]); const float lr = lam_re[g * 64 + p] * dt, li = lam_im[g * 64 + p] * dt;
    const float e32 = expf(lr * 32.0f), ar = e32 * cosf(li * 32.0f), ai = e32 * sinf(li * 32.0f);
    const float e512 = expf(lr * 512.0f), br = e512 * cosf(li * 512.0f), bi = e512 * sinf(li * 512.0f);
#pragma unroll 1
    for (int bb = 0; bb < 2; ++bb) { const int b = 2 * pm + bb;
        const float* sp = sloc + ((size_t)g * NCH + b * 128 + 16 * wave) * 128 + p;
        float sr[16], si[16];
#pragma unroll
        for (int c = 0; c < 16; ++c) { sr[c] = __hip_atomic_load(sp + c * 128, __ATOMIC_RELAXED, __HIP_MEMORY_SCOPE_AGENT); si[c] = __hip_atomic_load(sp + c * 128 + 64, __ATOMIC_RELAXED, __HIP_MEMORY_SCOPE_AGENT); }
        float xr = 0.f, xi = 0.f;
#pragma unroll
        for (int c = 0; c < 16; ++c) { const float t = ar * xr - ai * xi + sr[c]; xi = ar * xi + ai * xr + si[c]; xr = t; }
        E[wave * 64 + p] = (f32x2){xr, xi};
        __syncthreads();
        xr = 0.f; xi = 0.f;
        for (int v = 0; v < wave; ++v) { const f32x2 e = E[v * 64 + p]; const float t = br * xr - bi * xi + e.x; xi = br * xi + bi * xr + e.y; xr = t; }
        bf16_t* ap = Ap + ((size_t)g * NCH + b * 128 + 16 * wave) * KT + 512 + p;
#pragma unroll
        for (int c = 0; c < 16; ++c) { ap[c * KT] = f2bf(xr); ap[c * KT + 64] = f2bf(xi);
            const float t = ar * xr - ai * xi + sr[c]; xi = ar * xi + ai * xr + si[c]; xr = t; }
        __syncthreads();
    }
}

constexpr int AT_KS = 128 * 72, AT_VS = 64 * 140;
__device__ __forceinline__ void attn_phase(const bf16_t* qkv, bf16_t* ao, float* lse, unsigned* queue, LAS unsigned char* lds, const int wv) {
    const int tid = opaque_tid(wv), wave = __builtin_amdgcn_readfirstlane(tid >> 6), lane = tid & 63;
    LAS bf16_t* Ks = (LAS bf16_t*)lds;
    LAS bf16_t* Vt = (LAS bf16_t*)(lds + 2 * AT_KS * 2);
    const int fr = lane & 15, fq = lane >> 4;
    const int lrow = tid >> 2, lseg = tid & 3;
    const int vpair = tid >> 3, vch = tid & 7;
    const int qi = 16 * wave + fr, kb0 = 32 * (wave >> 1);
    volatile LAS unsigned* qslot = (volatile LAS unsigned*)(lds + STAGE_BYTES + 32);
    for (;;) {
        if (tid == 0) qslot[0] = __hip_atomic_fetch_add(queue, 1u, __ATOMIC_RELAXED, __HIP_MEMORY_SCOPE_AGENT);
        asm volatile("s_waitcnt vmcnt(0) lgkmcnt(0)" ::: "memory"); __builtin_amdgcn_s_barrier(); asm volatile("" ::: "memory");
        const int item = (int)qslot[0];
        if (item >= NB * NHEAD * 12) break;
        const int bh = item / 12, sub = item % 12, kind = sub >> 2, q = sub & 3;
        const int b = bh >> 3, h = bh & 7;
        const bf16_t* base = qkv + (size_t)b * SEQ * QKVW + h * 64;
        const int pre = (kind == 0 && q > 0) ? 1 : 0, nent = 8 + pre;
        const int d = kind == 0 ? 1 : (kind == 1 ? 4 : 16);
        u32x4 k0, k1, v0, v1; bf16x8 qn0, qn1, qc0, qc1;
#define AT_ENTRY(j_, r_, bi_) const int e_ = (j_) - pre; const int r_ = kind == 0 ? 0 : (kind == 1 ? q : 4 * q + (e_ >> 1)); const int bi_ = kind == 0 ? 8 * q + e_ : (kind == 1 ? e_ : (e_ & 1));
#define AT_LOAD(j_) do { AT_ENTRY(j_, r__, bi__) \
            const bf16_t* src = base + (size_t)((128 * bi__ + lrow) * d + r__) * QKVW + lseg * 16; \
            k0 = *(const u32x4*)(src + 512); k1 = *(const u32x4*)(src + 520); \
            const bf16_t* vsrc = base + (size_t)((128 * bi__ + 2 * vpair) * d + r__) * QKVW + 1024 + vch * 8; v0 = *(const u32x4*)vsrc; v1 = *(const u32x4*)(vsrc + (size_t)d * QKVW); \
            const bf16_t* qp = base + (size_t)((128 * bi__ + qi) * d + r__) * QKVW + 8 * fq; qn0 = *(const bf16x8*)qp; qn1 = *(const bf16x8*)(qp + 32); } while (0)
        AT_LOAD(0);
        for (int j = 0; j < nent; ++j) {
            AT_ENTRY(j, r, bi)
            const int slot = bi & 1;
            asm volatile("s_waitcnt lgkmcnt(0)" ::: "memory"); __builtin_amdgcn_s_barrier(); asm volatile("" ::: "memory");
            { LAS bf16_t* kd = Ks + slot * AT_KS + lrow * 72 + lseg * 16; *(LAS u32x4*)kd = k0; *(LAS u32x4*)(kd + 8) = k1;
              LAS unsigned* vd = (LAS unsigned*)(Vt + slot * AT_VS + (vch * 8) * 140 + 2 * vpair);
#pragma unroll
              for (int e = 0; e < 4; ++e) { vd[(2 * e) * 70] = (v0[e] & 0xffffu) | (v1[e] << 16); vd[(2 * e + 1) * 70] = (v0[e] >> 16) | (v1[e] & 0xffff0000u); } }
            qc0 = qn0; qc1 = qn1;
            if (j + 1 < nent) AT_LOAD(j + 1);
            asm volatile("s_waitcnt lgkmcnt(0)" ::: "memory"); __builtin_amdgcn_s_barrier(); asm volatile("" ::: "memory");
            if (j >= pre) {
                f32x4 s[10];
#pragma unroll
                for (int t = 0; t < 10; ++t) { const int kj0 = kb0 + 16 * t;
                    if ((kj0 < 128 && bi == 0) || (t == 0 && (wave & 1)) || (t == 9 && !(wave & 1))) { s[t] = (f32x4){-INFINITY, -INFINITY, -INFINITY, -INFINITY}; }
                    else { const int sl = kj0 < 128 ? (slot ^ 1) : slot;
                        const LAS bf16_t* kp = Ks + sl * AT_KS + ((kj0 & 127) + fr) * 72 + 8 * fq;
                        const bf16x8 ka = *(const LAS bf16x8*)kp, kb = *(const LAS bf16x8*)(kp + 32);
                        f32x4 z = (f32x4){0.f, 0.f, 0.f, 0.f};
                        z = __builtin_amdgcn_mfma_f32_16x16x32_bf16(ka, qc0, z, 0, 0, 0); z = __builtin_amdgcn_mfma_f32_16x16x32_bf16(kb, qc1, z, 0, 0, 0);
#pragma unroll
                        for (int jj = 0; jj < 4; ++jj) { const int kj = kj0 + 4 * fq + jj;
                            if (t <= 1) z[jj] = (kj >= qi) ? z[jj] : -INFINITY;
                            if (t >= 8) z[jj] = (kj <= qi + 128) ? z[jj] : -INFINITY; }
                        s[t] = z; } }
                float mx = -INFINITY;
#pragma unroll
                for (int t = 0; t < 10; ++t) mx = fmaxf(mx, fmaxf(fmaxf(s[t][0], s[t][1]), fmaxf(s[t][2], s[t][3])));
                mx = fmaxf(mx, shx(mx, 16, lane)); mx = fmaxf(mx, shx(mx, 32, lane));
                float l = 0.f;
#pragma unroll
                for (int t = 0; t < 10; ++t)
#pragma unroll
                    for (int jj = 0; jj < 4; ++jj) { const float pv = __builtin_amdgcn_exp2f(s[t][jj] - mx); s[t][jj] = pv; l += pv; }
                l += shx(l, 16, lane); l += shx(l, 32, lane);
                f32x4 o[4];
#pragma unroll
                for (int dt = 0; dt < 4; ++dt) o[dt] = (f32x4){0.f, 0.f, 0.f, 0.f};
#pragma unroll
                for (int g = 0; g < 5; ++g) { const int key0 = kb0 + 32 * g;
                    if (!(key0 < 128 && bi == 0)) { const int sl = key0 < 128 ? (slot ^ 1) : slot;
                        const u32x4 pw = pack8(s[2 * g], s[2 * g + 1]); const bf16x8 pf = __builtin_bit_cast(bf16x8, pw);
#pragma unroll
                        for (int dt = 0; dt < 4; ++dt) { const LAS bf16_t* vp = Vt + sl * AT_VS + (16 * dt + fr) * 140 + (key0 & 127) + 4 * fq;
                            const u32x2 va = *(const LAS u32x2*)vp, vb = *(const LAS u32x2*)(vp + 16);
                            const bf16x8 vf = __builtin_bit_cast(bf16x8, (u32x4){va.x, va.y, vb.x, vb.y});
                            o[dt] = __builtin_amdgcn_mfma_f32_16x16x32_bf16(vf, pf, o[dt], 0, 0, 0); } } }
                const float inv = 1.0f / l;
                const size_t orow = (size_t)kind * MT + (size_t)b * SEQ + (size_t)((128 * bi + qi) * d + r);
                bf16_t* op = ao + orow * DATT + h * 64 + 4 * fq;
#pragma unroll
                for (int dt = 0; dt < 4; ++dt) { u32x2 w; w.x = cvt_pk_bf16(o[dt][0] * inv, o[dt][1] * inv); w.y = cvt_pk_bf16(o[dt][2] * inv, o[dt][3] * inv); *(u32x2*)(op + 16 * dt) = w; }
                if (fq == 0) lse[orow * 8 + h] = mx + __builtin_amdgcn_logf(l);
            }
        }
#undef AT_LOAD
#undef AT_ENTRY
    }
    asm volatile("s_waitcnt lgkmcnt(0)" ::: "memory"); __builtin_amdgcn_s_barrier(); asm volatile("" ::: "memory");
}

#define XB_TMO      128
#define XB_XCNT(j)  (256  + 64 * (j))
#define XB_XSUB(j)  (1280 + 64 * (j))
#define XB_XGEN(j)  (2304 + 64 * (j))
#define XB_TOP      3328
#define XB_TOPGEN   3392
#define XCD_BAR_WORDS 3456
#define XB_SPIN_CAP (1u << 18)

__device__ __forceinline__ unsigned xb_ld(unsigned* p)              { return __hip_atomic_load(p, __ATOMIC_RELAXED, __HIP_MEMORY_SCOPE_AGENT); }
__device__ __forceinline__ unsigned xb_add(unsigned* p, unsigned v) { return __hip_atomic_fetch_add(p, v, __ATOMIC_RELAXED, __HIP_MEMORY_SCOPE_AGENT); }
__device__ __forceinline__ unsigned xb_xcc_id() { return (unsigned)__builtin_amdgcn_s_getreg((3 << 11) | 20) & 0xFu; }
#define XB_SPIN(cond, bar) do { unsigned _sp = 0; while (cond) { __builtin_amdgcn_s_sleep(1); \
    if ((++_sp & 255u) == 0u) { if (xb_ld(&(bar)[XB_TMO])) break; if (_sp > XB_SPIN_CAP) { atomicAdd(&(bar)[XB_TMO], 1u); break; } } } } while (0)

struct XcdBarrier {
    unsigned* bar; unsigned x;
    volatile LAS unsigned* st;
};

__device__ __forceinline__ XcdBarrier xcd_barrier_post(unsigned* bar, volatile LAS unsigned* st) {
    XcdBarrier b; b.bar = bar; b.x = xb_xcc_id(); b.st = st;
    if (threadIdx.x == 0) (void)xb_add(&bar[XB_XCNT(b.x)], 1u);
    return b;
}
__device__ __forceinline__ void xcd_barrier_complete(unsigned* bar, unsigned x, unsigned& nloc, unsigned& nx) {
    const unsigned G = gridDim.x * gridDim.y * gridDim.z;
    unsigned sum, cnt, mine, sp = 0u;
    for (;;) {
        sum = 0u; cnt = 0u; mine = 0u;
#pragma unroll
        for (unsigned j = 0; j < 16; ++j) { const unsigned c = xb_ld(&bar[XB_XCNT(j)]); sum += c; cnt += (c > 0u) ? 1u : 0u; mine = (j == x) ? c : mine; }
        if (sum == G) break;
        __builtin_amdgcn_s_sleep(1);
        if ((++sp & 255u) == 0u) { if (xb_ld(&bar[XB_TMO])) break; if (sp > XB_SPIN_CAP) { atomicAdd(&bar[XB_TMO], 1u); break; } }
    }
    nloc = mine > 0u ? mine : 1u; nx = cnt > 0u ? cnt : 1u;
}

__device__ __forceinline__ void xcd_barrier(const XcdBarrier& b, const int wv) {
    asm volatile("s_waitcnt vmcnt(0)" ::: "memory");
    __syncthreads();
    if (opaque_tid(wv) == 0) {
        unsigned* bar = b.bar;
        __builtin_amdgcn_s_waitcnt(0);
        unsigned nloc = b.st[0], nx = b.st[1];
        if (nloc == 0u) { xcd_barrier_complete(bar, b.x, nloc, nx); b.st[0] = nloc; b.st[1] = nx; }
        const unsigned old = xb_add(&bar[XB_XSUB(b.x)], 1u);
        const unsigned gen = old / nloc;
        if (old + 1u == (gen + 1u) * nloc) {
            __builtin_amdgcn_fence(__ATOMIC_RELEASE, "agent");
            asm volatile("s_waitcnt vmcnt(0)" ::: "memory");
            const unsigned og = xb_add(&bar[XB_TOP], 1u);
            const unsigned tg = og / nx;
            if (og + 1u == (tg + 1u) * nx) xb_add(&bar[XB_TOPGEN], 1u);
            else XB_SPIN(xb_ld(&bar[XB_TOPGEN]) == tg, bar);
            __builtin_amdgcn_fence(__ATOMIC_ACQUIRE, "agent");
            xb_add(&bar[XB_XGEN(b.x)], 1u);
            asm volatile("s_waitcnt vmcnt(0)" ::: "memory");
        } else {
            XB_SPIN(xb_ld(&bar[XB_XGEN(b.x)]) == gen, bar);
            __builtin_amdgcn_fence(__ATOMIC_ACQUIRE, "agent");
            asm volatile("s_waitcnt vmcnt(0)" ::: "memory");
        }
    }
    __syncthreads();
}


#define GEMM_RUN(EpiT_, SchedT_, g_, S_, E_) gemm_phase<EpiT_, SchedT_, true, true>(lds, g_, S_, E_, wv)
__device__ __forceinline__ void fused_gemm(LAS unsigned char* lds, const bf16_t* A, int lda, const bf16_t* Bt, int K, bf16_t* H, float* OUTF, float* RS, const bf16_t* UP, const float* gpost,
                                           float scale, int xmode, unsigned char* xw, unsigned use1, unsigned use2, int G, int c, const int wv) {
    Gemm g{A, Bt, lda, K, K, 0, 0}; StaticOrder S; S.init(MT, DM, G, c);
    EpiFuse E{lds, 0, H, OUTF, RS, UP, gpost, scale, xmode, xw, use1 + 1u, use2 + 1u};
    gemm_phase<EpiFuse, StaticOrder, true, true>(lds, g, S, E, wv);
}
struct Ptrs { unsigned char *ws, *wb, *xw; float* RS; bf16_t *HB, *XN, *F, *PB, *ACT, *QKV, *AP, *YG, *SSMO, *AO; float *SLOC, *LSE; };
__device__ __forceinline__ Ptrs mkptrs(unsigned char* ws) {
    asm volatile("" : "+s"(ws));
    Ptrs P; P.ws = ws; P.wb = ws + WS_W; P.xw = ws + WS_EXCH; unsigned char* big = ws + WS_BIG;
    P.RS = (float*)(ws + WS_RS); P.HB = (bf16_t*)(ws + WS_HB); P.XN = (bf16_t*)(ws + WS_XN); P.F = (bf16_t*)(big + B_AO);     P.PB = (bf16_t*)(ws + WS_PB);
    P.ACT = (bf16_t*)(big + B_ACT); P.QKV = (bf16_t*)(big + B_QKV); P.AP = (bf16_t*)(big + B_AP); P.SLOC = (float*)(big + B_SLOC);
    P.YG = (bf16_t*)(big + B_YG); P.SSMO = (bf16_t*)(big + B_SSMO); P.AO = (bf16_t*)(big + B_AO); P.LSE = (float*)(big + B_LSE);
    return P;
}
#define PH_BEGIN const KA ka = kargs(); const Ptrs P = mkptrs(kws(ka)); float* H = kout(ka); (void)H; int l = l_; asm volatile("" : "+s"(l)); int G = gridDim.x, c = blockIdx.x; asm volatile("" : "+s"(G), "+s"(c)); (void)G; (void)c; (void)l; (void)P

__global__ void __launch_bounds__(NTHREADS, 2) hybrid_fwd(Args a) {
    extern __shared__ __attribute__((aligned(16))) unsigned char lds_raw[];
    LAS unsigned char* lds = (LAS unsigned char*)lds_raw;
    cg::grid_group grid = cg::this_grid();
    const int wv = __builtin_amdgcn_readfirstlane((int)threadIdx.x >> 6);
    volatile LAS unsigned* xst = (volatile LAS unsigned*)(lds + STAGE_BYTES);
    if (threadIdx.x == 0) { xst[0] = 0u; xst[1] = 0u; }
    __syncthreads();
    const XcdBarrier xb = xcd_barrier_post((unsigned*)(kws(kargs()) + WS_EXCH + X_BAR), xst);
    { const int l_ = 0; PH_BEGIN;
      prep_layer<true>(ka, 0, lds, wv);
      row_phase(kin(ka, 0), P.HB, P.RS, wv); }
    grid.sync();

#pragma unroll 1
    for (int l_ = 0; l_ < DEPTH; ++l_) {
        { PH_BEGIN; Gemm g{P.HB, (const bf16_t*)(P.wb + W_GU1), DM, DM, DM, 0, 0}; StaticOrder S; S.init(MT, 2 * DFF, G, c); EpiSwiglu E{P.ACT, P.RS}; GEMM_RUN(EpiSwiglu, StaticOrder, g, S, E); }
        xcd_barrier(xb, wv);
        { PH_BEGIN; fused_gemm(lds, P.ACT, DFF, (const bf16_t*)(P.wb + W_D1), DFF, P.HB, nullptr, P.RS, nullptr, kin(ka, 7) + l * DM, 0.5f, 1, P.xw, 4u * l + 0u, 3u * l + 0u, G, c, wv); }
        xcd_barrier(xb, wv);
        { PH_BEGIN; Gemm g{P.HB, (const bf16_t*)(P.wb + W_IN), DM, DM, DM, 0, 0}; StaticOrder S; S.init(MT, DIN, G, c); EpiWin E{P.QKV, P.AP, (const f32x4*)(P.ws + WS_ROT), P.RS}; GEMM_RUN(EpiWin, StaticOrder, g, S, E); }
        xcd_barrier(xb, wv);
        { PH_BEGIN; Gemm g{P.AP, (const bf16_t*)(P.wb + W_W1), KT, 512, 512, (size_t)NCH * KT * 2, (size_t)256 * 512 * 2}; BatchOrder S{4, 1, NGRP, G, c}; EpiSloc E{P.SLOC}; GEMM_RUN(EpiSloc, BatchOrder, g, S, E);
          if (c < NGRP * 4) scan_own(c >> 2, c & 3, kin(ka, 11) + l * 2048, kin(ka, 12) + l * 2048, kin(ka, 13) + l * 32, P.SLOC, P.AP, lds, wv); }
        { PH_BEGIN; asm volatile("s_waitcnt vmcnt(0)" ::: "memory"); __syncthreads();
          Gemm g{P.AP, (const bf16_t*)(P.wb + W_T), KT, KT, KT, (size_t)NCH * KT * 2, (size_t)512 * KT * 2}; OwnTOrder S{c >> 2, c & 3, c < NGRP * 4}; EpiT E{P.YG}; GEMM_RUN(EpiT, OwnTOrder, g, S, E); }
        { PH_BEGIN; attn_phase(P.QKV, P.AO, P.LSE, (unsigned*)(P.xw + X_CNT) + 64 * l, lds, wv); }
        xcd_barrier(xb, wv);
        { PH_BEGIN; Gemm g{P.YG, (const bf16_t*)(P.wb + W_GLU), DSSM, DSSM, DSSM, 0, 0}; StaticOrder S; S.init(MT, DSSM, G, c); EpiGlu E{P.YG, kin(ka, 20) + l * DSSM, P.SSMO}; GEMM_RUN(EpiGlu, StaticOrder, g, S, E); }
        xcd_barrier(xb, wv);
        { PH_BEGIN; mix_rows(P.AO, P.LSE, P.SSMO, kin(ka, 10) + l * DATT, kin(ka, 21) + l * DSSM, P.XN, wv); }
        xcd_barrier(xb, wv);
        { PH_BEGIN; fused_gemm(lds, P.XN, DM, (const bf16_t*)(P.wb + W_OUT), DM, P.HB, nullptr, P.RS, nullptr, kin(ka, 23) + l * DM, 1.0f, 1, P.xw, 4u * l + 1u, 3u * l + 1u, G, c, wv); }
        xcd_barrier(xb, wv);
        { PH_BEGIN; Gemm g{P.HB, (const bf16_t*)(P.wb + W_GU2), DM, DM, DM, 0, 0}; StaticOrder S; S.init(MT, 2 * DFF, G, c); EpiSwiglu E{P.ACT, P.RS}; GEMM_RUN(EpiSwiglu, StaticOrder, g, S, E); }
        { PH_BEGIN; Gemm g{P.PB, (const bf16_t*)(P.wb + W_PUP), PLE, PLE, PLE, 0, 0}; StaticOrder S; S.init(MT, DM, G, c); EpiBf16 E{P.F, DM}; GEMM_RUN(EpiBf16, StaticOrder, g, S, E); }
        xcd_barrier(xb, wv);
        { PH_BEGIN; fused_gemm(lds, P.ACT, DFF, (const bf16_t*)(P.wb + W_D2), DFF, P.HB, nullptr, P.RS, nullptr, kin(ka, 28) + l * DM, 0.5f, 0, P.xw, 4u * l + 2u, 0u, G, c, wv); }
        xcd_barrier(xb, wv);
        { PH_BEGIN; fused_gemm(lds, P.HB, DM, (const bf16_t*)(P.wb + W_PG), DM, P.HB, l + 1 < DEPTH ? nullptr : H, P.RS, P.F, kin(ka, 31) + l * DM, 1.0f, l + 1 < DEPTH ? 1 : 0, P.xw, 4u * l + 3u, 3u * l + 2u, G, c, wv); }
        if (l_ + 1 < DEPTH) {
            xcd_barrier(xb, wv);
            { PH_BEGIN; prep_layer<false>(ka, l + 1, lds, wv); }
            xcd_barrier(xb, wv);
        }
    }
}

extern "C" void kernel_launch(void* const* d_in, const int* in_sizes, int n_in, void* d_out, int out_size, void* d_ws, size_t ws_size, hipStream_t stream) {
    static int grid = 0;
    if (grid == 0) {
        if (n_in != 32 || out_size != MT * DM || ws_size < WS_END) { fprintf(stderr, "kernel_launch: unexpected shapes (n_in %d out %d ws %zu, need %zu)\n", n_in, out_size, ws_size, (size_t)WS_END); grid = -1; return; }
        int dev = 0, cus = 0, per_cu = 0;
        if (hipGetDevice(&dev) != hipSuccess || hipDeviceGetAttribute(&cus, hipDeviceAttributeMultiprocessorCount, dev) != hipSuccess) { grid = -1; return; }
        if (hipFuncSetAttribute((const void*)hybrid_fwd, hipFuncAttributeMaxDynamicSharedMemorySize, LDS_BYTES) != hipSuccess) { fprintf(stderr, "kernel_launch: hipFuncSetAttribute failed\n"); grid = -1; return; }
        if (hipOccupancyMaxActiveBlocksPerMultiprocessor(&per_cu, (const void*)hybrid_fwd, NTHREADS, LDS_BYTES) != hipSuccess || per_cu < 1) { fprintf(stderr, "kernel_launch: occupancy query says %d\n", per_cu); per_cu = 1; }
        (void)hipGetLastError();
        grid = cus * 1; if (grid != 256) fprintf(stderr, "kernel_launch: built for 256 CUs, got %d\n", grid);
    }
    if (grid < 0) return;
    if (hipMemsetAsync((unsigned char*)d_ws + WS_EXCH, 0, X_BAR + 16384, stream) != hipSuccess) { fprintf(stderr, "kernel_launch: memset failed\n"); return; }
    Args a{};
    for (int i = 0; i < 32; ++i) a.in[i] = (const float*)d_in[i];
    a.out = (float*)d_out; a.ws = (unsigned char*)d_ws;
    void* args[] = {&a};
    hipError_t e = hipLaunchCooperativeKernel((const void*)hybrid_fwd, dim3(grid), dim3(NTHREADS), args, LDS_BYTES, stream);
    if (e != hipSuccess) fprintf(stderr, "cooperative launch failed: %s (grid %d)\n", hipGetErrorString(e), grid);
}
```

```cpp
#include <hip/hip_runtime.h>
#include <hip/hip_cooperative_groups.h>
#include <cstdio>
#include <cstdint>
namespace cg = cooperative_groups;

#define LAS __attribute__((address_space(3)))
#define PG8_LAS LAS
typedef unsigned short bf16_t;
typedef short bf16x8 __attribute__((ext_vector_type(8)));
typedef float f32x4 __attribute__((ext_vector_type(4)));
typedef float f32x2 __attribute__((ext_vector_type(2)));
typedef unsigned u32x4 __attribute__((ext_vector_type(4)));
typedef unsigned u32x2 __attribute__((ext_vector_type(2)));

constexpr int NB = 8, SEQ = 4096, DM = 1024, MT = NB * SEQ, DEPTH = 4, DATT = 512, NHEAD = 8, DSSM = 512, NGRP = 32, NSTATE = 64;
constexpr int DFF = 2816, DIN = 2048, PLE = 256, QKVW = 1536;
constexpr int CH = 32, NCH = MT / CH  , KT = 640  ;
constexpr float EPS = 1e-6f;
constexpr int NTHREADS = 512, LDS_BYTES = 131072 + 64 + 5120;
constexpr int LDS_TAB = 131072 + 64;

constexpr size_t MiB = (size_t)1 << 20;
constexpr size_t WS_XN = 0, WS_F = 64 * MiB, WS_PB = 128 * MiB, WS_ROT = 144 * MiB, WS_W = 146 * MiB, WS_BIG = 216 * MiB, WS_EXCH = 531 * MiB, WS_HB = WS_F, WS_RS = 534 * MiB, WS_END = 536 * MiB;
constexpr size_t X_B1 = 0, X_B2 = 1024 * 1024, X_CNT = 2048 * 1024, X_BAR = 2048 * 1024 + 65536;
constexpr size_t W_GU1 = 0, W_D1 = 11534336, W_IN = 17301504, W_GLU = 21495808, W_OUT = 22020096, W_GU2 = 24117248, W_D2 = 35651584, W_PUP = 41418752, W_PG = 41943040,
                 W_T = 44040192, W_W1 = 65011712;
constexpr size_t B_ACT = 0, B_QKV = 0, B_AP = 96 * MiB, B_SLOC = 136 * MiB, B_YG = 152 * MiB, B_SSMO = 184 * MiB, B_AO = 216 * MiB, B_LSE = 312 * MiB;

struct Args { const float* in[32]; float* out; unsigned char* ws; };
typedef const __attribute__((address_space(4))) unsigned char* KA;
typedef const float* cfptr_t; typedef unsigned char* ucptr_t; typedef float* fptr_t;
__device__ __forceinline__ KA kargs() { KA k = (KA)__builtin_amdgcn_kernarg_segment_ptr(); asm volatile("" : "+s"(k)); return k; }
__device__ __forceinline__ const float* kin(KA k, int i) { return *(const __attribute__((address_space(4))) cfptr_t*)(k + 8 * i); }
__device__ __forceinline__ float* kout(KA k) { return *(const __attribute__((address_space(4))) fptr_t*)(k + 256); }
__device__ __forceinline__ unsigned char* kws(KA k) { return *(const __attribute__((address_space(4))) ucptr_t*)(k + 264); }

__device__ __forceinline__ unsigned cvt_pk_bf16(float lo, float hi) { unsigned r; asm volatile("v_cvt_pk_bf16_f32 %0, %1, %2" : "=v"(r) : "v"(lo), "v"(hi)); return r; }
__device__ __forceinline__ float bf_lo(unsigned w) { return __uint_as_float(w << 16); }
__device__ __forceinline__ float bf_hi(unsigned w) { return __uint_as_float(w & 0xffff0000u); }
__device__ __forceinline__ bf16_t f2bf(float f) { unsigned u = __float_as_uint(f); u += 0x7FFFu + ((u >> 16) & 1u); return (bf16_t)(u >> 16); }
__device__ __forceinline__ float shx(float v, int mask, int lane) { return __int_as_float(__builtin_amdgcn_ds_bpermute((lane ^ mask) << 2, __float_as_int(v))); }
__device__ __forceinline__ float wave_sum(float v, int lane) {
#pragma unroll
    for (int o = 1; o < 64; o <<= 1) v += shx(v, o, lane);
    return v;
}
__device__ __forceinline__ float fsigmoid(float x) { return __builtin_amdgcn_rcpf(1.0f + __builtin_amdgcn_exp2f(-1.44269504f * x)); }
__device__ __forceinline__ u32x4 pack8(const f32x4 a, const f32x4 b) { u32x4 w; w.x = cvt_pk_bf16(a[0], a[1]); w.y = cvt_pk_bf16(a[2], a[3]); w.z = cvt_pk_bf16(b[0], b[1]); w.w = cvt_pk_bf16(b[2], b[3]); return w; }
__device__ __forceinline__ void unpack8(const u32x4 w, f32x4& a, f32x4& b) { a = (f32x4){bf_lo(w.x), bf_hi(w.x), bf_lo(w.y), bf_hi(w.y)}; b = (f32x4){bf_lo(w.z), bf_hi(w.z), bf_lo(w.w), bf_hi(w.w)}; }
__device__ __forceinline__ int opaque_tid(int wv) { unsigned m = ~0u; asm volatile("" : "+s"(m)); int t = wv * 64 + (int)__builtin_amdgcn_mbcnt_hi(m, __builtin_amdgcn_mbcnt_lo(m, 0u)); asm volatile("" : "+v"(t)); return t; }
#define LDS_FENCE() asm volatile("s_waitcnt lgkmcnt(0)" ::: "memory")

constexpr int BM = 256, BK = 64, HALF = 128, HTB = HALF * BK * 2  , STAGE_BYTES = 8 * HTB, NXCD = 8, WGM = 8;
__host__ __device__ __forceinline__ int lds_byte(int r, int c) { const int st = (r >> 4) * 2 + (c >> 5), rr = r & 15, cc = c & 31, ob = rr * 64 + cc * 2; return st * 1024 + (ob ^ (((ob >> 9) & 1) << 5)); }
__host__ __device__ __forceinline__ void stage_rc(int b, int& R, int& C) { const int st = b / 1024, sb = b % 1024, swz = sb ^ (((sb >> 9) & 1) << 5); R = (st >> 1) * 16 + swz / 64; C = (st & 1) * 32 + (swz % 64) / 2; }
__host__ __device__ __forceinline__ int perm32(int rho) { const int n = rho >> 4, i = rho & 15; return 8 * (i >> 2) + 4 * n + (i & 3); }

struct Unit { int pm, pn, z; };
struct Gemm { const bf16_t* A; const bf16_t* Bt; int lda, ldb, K; size_t zA, zB; };

struct StaticOrder {
    int nM, nN, nwg, G, c;
    __device__ void init(int M, int N, int G_, int c_) { nM = M / BM; nN = N / BM; nwg = nM * nN; G = G_; c = c_; }
    __device__ bool next(int i, Unit& u) const {
        const long L = (long)i * G + c; if (L >= nwg) return false;
        int wgid = (int)L; { const int q = nwg / NXCD, r = nwg % NXCD, xcd = wgid % NXCD, off = wgid / NXCD; wgid = (xcd < r ? xcd * (q + 1) : r * (q + 1) + (xcd - r) * q) + off; }
        const int nig = WGM * nN, gid = wgid / nig, fm = gid * WGM, gsz = (nM - fm) < WGM ? (nM - fm) : WGM;
        u.pm = fm + ((wgid % nig) % gsz); u.pn = (wgid % nig) / gsz; u.z = 0; return true;
    }
    __device__ __forceinline__ void a_ready(const Unit&) const {}
    __device__ __forceinline__ void done(const Unit&) const {}
};
struct OwnTOrder {
    int z, pm, active;
    __device__ bool next(int i, Unit& u) const { if (!active || i >= 2) return false; u.z = z; u.pm = pm; u.pn = i; return true; }
    __device__ __forceinline__ void a_ready(const Unit&) const {}
    __device__ __forceinline__ void done(const Unit&) const {}
};
struct BatchOrder {
    int nM, nN, nZ, G, c;
    __device__ bool next(int i, Unit& u) const {
        const int L = i * G + c, per = nM * nN; if (L >= per * nZ) return false;
        u.z = L / per; const int t = L % per; u.pm = t % nM; u.pn = t / nM; return true;
    }
    __device__ __forceinline__ void a_ready(const Unit&) const {}
    __device__ __forceinline__ void done(const Unit&) const {}
};
typedef f32x4 AccT[2][2][4][2];


__device__ __forceinline__ f32x4 row_part4(const float* rs16, int r, int fq) { return *(const f32x4*)(rs16 + (size_t)r * 16 + 4 * fq); }
__device__ __forceinline__ float row_rstd4(const f32x4 p, int lane) { float t = (p[0] + p[1]) + (p[2] + p[3]); t += shx(t, 16, lane); t += shx(t, 32, lane); return 1.0f / sqrtf(t * (1.0f / DM) + EPS); }
struct EpiBf16 {
    static constexpr bool PERM = true, AFTER_DRAIN = false;
    bf16_t* O; int ldc;
    __device__ __forceinline__ void operator()(const AccT& acc, const Unit& u, int wr, int wc, int fr, int fq) const {
        const int row0 = u.pm * BM + wr * 64 + fr, col0 = u.pn * BM + wc * 32 + 8 * fq;
#pragma unroll
        for (int ai = 0; ai < 2; ++ai)
#pragma unroll
            for (int m = 0; m < 4; ++m) { bf16_t* rowp = O + (size_t)(row0 + ai * HALF + m * 16) * ldc + col0;
#pragma unroll
                for (int bj = 0; bj < 2; ++bj) *(u32x4*)(rowp + bj * HALF) = pack8(acc[ai][bj][m][0], acc[ai][bj][m][1]); }
    }
};
struct EpiSwiglu {
    static constexpr bool PERM = true, AFTER_DRAIN = false;
    bf16_t* O; const float* rs16;
    __device__ __forceinline__ void operator()(const AccT& acc, const Unit& u, int wr, int wc, int fr, int fq) const {
        const int row0 = u.pm * BM + wr * 64 + fr, col0 = u.pn * HALF + wc * 32 + 8 * fq, lane = fq * 16 + fr;
        f32x4 rp[2][4];
#pragma unroll
        for (int ai = 0; ai < 2; ++ai)
#pragma unroll
            for (int m = 0; m < 4; ++m) rp[ai][m] = row_part4(rs16, row0 + ai * HALF + m * 16, fq);
#pragma unroll
        for (int ai = 0; ai < 2; ++ai)
#pragma unroll
            for (int m = 0; m < 4; ++m) { bf16_t* rowp = O + (size_t)(row0 + ai * HALF + m * 16) * DFF + col0; const float rr = row_rstd4(rp[ai][m], lane);
                f32x4 o0, o1;
#pragma unroll
                for (int j = 0; j < 4; ++j) { const float g0 = acc[ai][0][m][0][j] * rr, g1 = acc[ai][0][m][1][j] * rr;
                    o0[j] = g0 * fsigmoid(g0) * (acc[ai][1][m][0][j] * rr); o1[j] = g1 * fsigmoid(g1) * (acc[ai][1][m][1][j] * rr); }
                *(u32x4*)rowp = pack8(o0, o1); }
    }
};
struct EpiWin {
    static constexpr bool PERM = true, AFTER_DRAIN = false;
    bf16_t* qkv; bf16_t* Ap; const f32x4* rot; const float* rs16;
    __device__ __forceinline__ void operator()(const AccT& acc, const Unit& u, int wr, int wc, int fr, int fq) const {
        const int row0 = u.pm * BM + wr * 64 + fr, lane = fq * 16 + fr;
        const int sec = u.pn >> 1;
        f32x4 rp[2][4];
#pragma unroll
        for (int ai = 0; ai < 2; ++ai)
#pragma unroll
            for (int m = 0; m < 4; ++m) rp[ai][m] = row_part4(rs16, row0 + ai * HALF + m * 16, fq);
        if (sec < 2) {
            const bool rotw = (wc & 1) == 0;
            const float sc = sec == 0 ? 0.18033688011112042f : 1.0f;
            const float sg = fq == 0 ? -1.0f : 1.0f;
#pragma unroll
            for (int ai = 0; ai < 2; ++ai)
#pragma unroll
                for (int m = 0; m < 4; ++m) { const int r = row0 + ai * HALF + m * 16; const float rr = row_rstd4(rp[ai][m], lane);
                    f32x4 cs[4];
#pragma unroll
                    for (int i = 0; i < 4; ++i) cs[i] = rotw ? rot[(size_t)r * 4 + i] : (f32x4){1.f, 0.f, 1.f, 0.f};
#pragma unroll
                    for (int bj = 0; bj < 2; ++bj) { f32x4 v0 = acc[ai][bj][m][0] * rr, v1 = acc[ai][bj][m][1] * rr;
                        if (rotw) {
#pragma unroll
                            for (int j = 0; j < 4; ++j) { const float p0 = shx(v0[j], 16, lane), p1 = shx(v1[j], 16, lane);
                                const float c0 = cs[j >> 1][(j & 1) * 2], s0 = cs[j >> 1][(j & 1) * 2 + 1], c1 = cs[2 + (j >> 1)][(j & 1) * 2], s1 = cs[2 + (j >> 1)][(j & 1) * 2 + 1];
                                const float r0 = v0[j] * c0 + sg * p0 * s0, r1 = v1[j] * c1 + sg * p1 * s1;
                                if (fq < 2) { v0[j] = r0; v1[j] = r1; } } }
                        v0 *= sc; v1 *= sc;
                        *(u32x4*)(qkv + (size_t)r * QKVW + u.pn * BM + bj * HALF + wc * 32 + 8 * fq) = pack8(v0, v1); } }
        } else if (sec == 2) {
#pragma unroll
            for (int ai = 0; ai < 2; ++ai)
#pragma unroll
                for (int m = 0; m < 4; ++m) { const int r = row0 + ai * HALF + m * 16; const float rr = row_rstd4(rp[ai][m], lane);
#pragma unroll
                    for (int bj = 0; bj < 2; ++bj) *(u32x4*)(qkv + (size_t)r * QKVW + u.pn * BM + bj * HALF + wc * 32 + 8 * fq) = pack8(acc[ai][bj][m][0] * rr, acc[ai][bj][m][1] * rr); }
        } else {
#pragma unroll
            for (int ai = 0; ai < 2; ++ai)
#pragma unroll
                for (int m = 0; m < 4; ++m) { const int r = row0 + ai * HALF + m * 16; const int R = r >> 5, sp = r & 31; const float rr = row_rstd4(rp[ai][m], lane);
#pragma unroll
                    for (int bj = 0; bj < 2; ++bj) { const int cu = (u.pn - 6) * BM + bj * HALF + wc * 32 + 8 * fq; const int g = cu >> 4, hh = cu & 15;
                        *(u32x4*)(Ap + ((size_t)g * NCH + R) * KT + sp * 16 + hh) = pack8(acc[ai][bj][m][0] * rr, acc[ai][bj][m][1] * rr); } }
        }
    }
};
struct EpiSloc {
    static constexpr bool PERM = false, AFTER_DRAIN = false;
    float* S;
    __device__ __forceinline__ void operator()(const AccT& acc, const Unit& u, int wr, int wc, int fr, int fq) const {
        const int row0 = u.pm * BM + wr * 64 + fr;
#pragma unroll
        for (int ai = 0; ai < 2; ++ai)
#pragma unroll
            for (int m = 0; m < 4; ++m) { float* rowp = S + ((size_t)u.z * NCH + row0 + ai * HALF + m * 16) * 128 + wc * 32 + 4 * fq;
#pragma unroll
                for (int n = 0; n < 2; ++n) *(f32x4*)(rowp + n * 16) = acc[ai][0][m][n]; }
    }
};
struct EpiT {
    static constexpr bool PERM = true, AFTER_DRAIN = false;
    bf16_t* Y;
    __device__ __forceinline__ void operator()(const AccT& acc, const Unit& u, int wr, int wc, int fr, int fq) const {
        const int row0 = u.pm * BM + wr * 64 + fr;
#pragma unroll
        for (int ai = 0; ai < 2; ++ai)
#pragma unroll
            for (int m = 0; m < 4; ++m) { const int R = row0 + ai * HALF + m * 16;
#pragma unroll
                for (int bj = 0; bj < 2; ++bj) { const int c = u.pn * BM + bj * HALF + wc * 32 + 8 * fq; const int tau = c >> 4, hh = c & 15;
                    f32x4 o0, o1;
#pragma unroll
                    for (int j = 0; j < 4; ++j) { const float x0 = acc[ai][bj][m][0][j], x1 = acc[ai][bj][m][1][j];
                        o0[j] = x0 * fsigmoid(1.5957691216f * (x0 + 0.044715f * x0 * x0 * x0)); o1[j] = x1 * fsigmoid(1.5957691216f * (x1 + 0.044715f * x1 * x1 * x1)); }
                    *(u32x4*)(Y + ((size_t)R * CH + tau) * DSSM + u.z * 16 + hh) = pack8(o0, o1); } }
    }
};
struct EpiGlu {
    static constexpr bool PERM = true, AFTER_DRAIN = false;
    const bf16_t* Y; const float* bias; bf16_t* O;
    __device__ __forceinline__ void operator()(const AccT& acc, const Unit& u, int wr, int wc, int fr, int fq) const {
        const int row0 = u.pm * BM + wr * 64 + fr, col0 = u.pn * BM + wc * 32 + 8 * fq;
#pragma unroll
        for (int ai = 0; ai < 2; ++ai)
#pragma unroll
            for (int m = 0; m < 4; ++m) { const size_t off = (size_t)(row0 + ai * HALF + m * 16) * DSSM + col0;
#pragma unroll
                for (int bj = 0; bj < 2; ++bj) { const f32x4 b0 = *(const f32x4*)(bias + col0 + bj * HALF), b1 = *(const f32x4*)(bias + col0 + bj * HALF + 4);
                    f32x4 y0, y1; unpack8(*(const u32x4*)(Y + off + bj * HALF), y0, y1);
                    f32x4 o0, o1;
#pragma unroll
                    for (int j = 0; j < 4; ++j) { o0[j] = y0[j] * fsigmoid(acc[ai][bj][m][0][j] + b0[j]); o1[j] = y1[j] * fsigmoid(acc[ai][bj][m][1][j] + b1[j]); }
                    *(u32x4*)(O + off + bj * HALF) = pack8(o0, o1); } }
    }
};
struct EpiPle {
    static constexpr bool PERM = true, AFTER_DRAIN = false;
    bf16_t* F;
    __device__ __forceinline__ void operator()(const AccT& acc, const Unit& u, int wr, int wc, int fr, int fq) const {
        const int row0 = u.pm * BM + wr * 64 + fr, col0 = u.pn * BM + wc * 32 + 8 * fq;
#pragma unroll
        for (int ai = 0; ai < 2; ++ai)
#pragma unroll
            for (int m = 0; m < 4; ++m) { const size_t off = (size_t)(row0 + ai * HALF + m * 16) * DM + col0;
#pragma unroll
                for (int bj = 0; bj < 2; ++bj) { f32x4 y0, y1; unpack8(*(const u32x4*)(F + off + bj * HALF), y0, y1);
                    f32x4 o0, o1;
#pragma unroll
                    for (int j = 0; j < 4; ++j) { o0[j] = y0[j] * fsigmoid(acc[ai][bj][m][0][j]); o1[j] = y1[j] * fsigmoid(acc[ai][bj][m][1][j]); }
                    *(u32x4*)(F + off + bj * HALF) = pack8(o0, o1); } }
    }
};

struct RowExch {
    unsigned long long* xbuf; unsigned tag;
    __device__ __forceinline__ void run(const float (&part)[2][4], int panel, int pn, int wr, int wc, int fr, int fq, LAS unsigned char* lds, int wid, int lane) const {
        LAS float* P = (LAS float*)(lds + LDS_TAB);
        LAS float* S = (LAS float*)(lds + LDS_TAB + 4096);
#pragma unroll
        for (int ai = 0; ai < 2; ++ai)
#pragma unroll
            for (int m = 0; m < 4; ++m) { float sv = part[ai][m]; sv += shx(sv, 16, lane); sv += shx(sv, 32, lane);
                if (fq == 0) P[(ai * HALF + wr * 64 + m * 16 + fr) * 4 + wc] = sv; }
        asm volatile("s_waitcnt lgkmcnt(0)" ::: "memory"); __builtin_amdgcn_s_barrier(); asm volatile("" ::: "memory");
        if (lane < 32) { const int row = wid * 32 + lane; const f32x4 p = *(const LAS f32x4*)(P + row * 4);
            unsigned long long* slot = xbuf + ((size_t)panel * 256 + row) * 4;
            __hip_atomic_store(slot + pn, ((unsigned long long)tag << 32) | (unsigned long long)__float_as_uint((p[0] + p[1]) + (p[2] + p[3])), __ATOMIC_RELAXED, __HIP_MEMORY_SCOPE_AGENT);
            float t = 0.f;
            for (unsigned spin = 0; spin < 200000u; ++spin) {
                const unsigned long long g0 = __hip_atomic_load(slot + 0, __ATOMIC_RELAXED, __HIP_MEMORY_SCOPE_AGENT), g1 = __hip_atomic_load(slot + 1, __ATOMIC_RELAXED, __HIP_MEMORY_SCOPE_AGENT),
                                         g2 = __hip_atomic_load(slot + 2, __ATOMIC_RELAXED, __HIP_MEMORY_SCOPE_AGENT), g3 = __hip_atomic_load(slot + 3, __ATOMIC_RELAXED, __HIP_MEMORY_SCOPE_AGENT);
                t = (__uint_as_float((unsigned)g0) + __uint_as_float((unsigned)g1)) + (__uint_as_float((unsigned)g2) + __uint_as_float((unsigned)g3));
                if ((unsigned)(g0 >> 32) == tag && (unsigned)(g1 >> 32) == tag && (unsigned)(g2 >> 32) == tag && (unsigned)(g3 >> 32) == tag) break;
                __builtin_amdgcn_s_sleep(1); }
            S[row] = t; }
        asm volatile("s_waitcnt vmcnt(0) lgkmcnt(0)" ::: "memory"); __builtin_amdgcn_s_barrier(); asm volatile("" ::: "memory");
    }
};
struct EpiFuse {
    static constexpr bool PERM = true, AFTER_DRAIN = false;
    LAS unsigned char* lds;
    __device__ __forceinline__ void operator()(const AccT& acc_, const Unit& u, int wr, int wc, int fr, int fq) const { fused(const_cast<AccT&>(acc_), u, wr, wc, fr, fq, lds, wr * 4 + wc, fq * 16 + fr); }
    int row_base; bf16_t* H; float* OUTF; float* RS; const bf16_t* UP; const float* gpost; float scale; int xmode;
    unsigned char* xw; unsigned tg1, tg2;
    __device__ __forceinline__ void fused(AccT& acc, const Unit& u, int wr, int wc, int fr, int fq, LAS unsigned char* lds, int wid, int lane) const {
        const int col0 = u.pn * BM + wc * 32 + 8 * fq, panel = (row_base >> 8) + u.pm;
        const int rloc0 = wr * 64 + fr; const size_t grow0 = (size_t)row_base + (size_t)u.pm * BM + rloc0;
        if (UP) {
#pragma unroll
            for (int ai = 0; ai < 2; ++ai)
#pragma unroll
                for (int m = 0; m < 4; ++m)
#pragma unroll
                    for (int bj = 0; bj < 2; ++bj) { f32x4 y0, y1; unpack8(*(const u32x4*)(UP + (grow0 + ai * HALF + m * 16) * DM + col0 + bj * HALF), y0, y1);
#pragma unroll
                        for (int j = 0; j < 4; ++j) { acc[ai][bj][m][0][j] = y0[j] * fsigmoid(acc[ai][bj][m][0][j]); acc[ai][bj][m][1][j] = y1[j] * fsigmoid(acc[ai][bj][m][1][j]); }
                        if (bj == 1 && (m & 1)) { asm volatile("" : "+v"(acc[ai][0][m][0]), "+v"(acc[ai][0][m][1]), "+v"(acc[ai][1][m][0]), "+v"(acc[ai][1][m][1]), "+v"(acc[ai][0][m - 1][0]), "+v"(acc[ai][0][m - 1][1]), "+v"(acc[ai][1][m - 1][0]), "+v"(acc[ai][1][m - 1][1])); asm volatile("" ::: "memory"); } }
        }
        float part[2][4];
#pragma unroll
        for (int ai = 0; ai < 2; ++ai)
#pragma unroll
            for (int m = 0; m < 4; ++m) { float sv = 0.f;
#pragma unroll
                for (int bj = 0; bj < 2; ++bj)
#pragma unroll
                    for (int n = 0; n < 2; ++n) { const f32x4 x = acc[ai][bj][m][n]; sv += (x[0] * x[0] + x[1] * x[1]) + (x[2] * x[2] + x[3] * x[3]); }
                part[ai][m] = sv; }
        asm volatile("" ::: "memory");
        size_t growh = grow0; asm volatile("" : "+v"(growh));
        u32x4 hr[4][2];
#pragma unroll
        for (int q = 0; q < 4; ++q)
#pragma unroll
            for (int bj = 0; bj < 2; ++bj) hr[q][bj] = *(const u32x4*)(H + (growh + q * 16) * DM + col0 + bj * HALF);
        { const RowExch e1{(unsigned long long*)(xw + X_B1), tg1}; e1.run(part, panel, u.pn, wr, wc, fr, fq, lds, wid, lane); }
        const LAS float* S = (const LAS float*)(lds + LDS_TAB + 4096);
        f32x4 gp[2][2];
#pragma unroll
        for (int bj = 0; bj < 2; ++bj) { gp[bj][0] = *(const f32x4*)(gpost + col0 + bj * HALF); gp[bj][1] = *(const f32x4*)(gpost + col0 + bj * HALF + 4); }
#pragma unroll
        for (int rg = 0; rg < 8; ++rg) { const int ai = rg >> 2, m = rg & 3, q = rg & 3;
            const int rl = rloc0 + ai * HALF + m * 16; const float rs = scale / sqrtf(S[rl] * (1.0f / DM) + EPS);
            bf16_t* hp = H + (growh + ai * HALF + m * 16) * DM + col0; float sv = 0.f;
#pragma unroll
            for (int bj = 0; bj < 2; ++bj) { f32x4 r0, r1; unpack8(hr[q][bj], r0, r1);
                const f32x4 h0 = r0 + acc[ai][bj][m][0] * gp[bj][0] * rs, h1 = r1 + acc[ai][bj][m][1] * gp[bj][1] * rs;
                *(u32x4*)(hp + bj * HALF) = pack8(h0, h1);
                if (OUTF) { float* op = OUTF + (growh + ai * HALF + m * 16) * DM + col0 + bj * HALF; *(f32x4*)op = h0; *(f32x4*)(op + 4) = h1; }
                acc[ai][bj][m][0] = h0; acc[ai][bj][m][1] = h1;
                sv += (h0[0] * h0[0] + h0[1] * h0[1]) + (h0[2] * h0[2] + h0[3] * h0[3]) + (h1[0] * h1[0] + h1[1] * h1[1]) + (h1[2] * h1[2] + h1[3] * h1[3]);
                if (rg + 4 < 8) hr[q][bj] = *(const u32x4*)(H + (growh + HALF + m * 16) * DM + col0 + bj * HALF); }
            part[ai][m] = sv;
            if (m == 3) asm volatile("" ::: "memory"); }
        if (xmode == 1) {
            size_t growx = grow0; asm volatile("" : "+v"(growx));
#pragma unroll
            for (int ai = 0; ai < 2; ++ai)
#pragma unroll
                for (int m = 0; m < 4; ++m) { float sv = part[ai][m]; sv += shx(sv, 16, lane); sv += shx(sv, 32, lane);
                    if (fq == 0) RS[(growx + ai * HALF + m * 16) * 16 + u.pn * 4 + wc] = sv; }
        }
    }
};

template <class Epi, class Sched, bool ALIGN_EPI = false, bool SP2 = false>
__device__ __forceinline__ void gemm_phase(PG8_LAS unsigned char* lds, const Gemm g, const Sched& S, const Epi& E, const int wv) {
    const int tid = opaque_tid(wv), wid = __builtin_amdgcn_readfirstlane(tid >> 6), lane = tid & 63, wr = wid >> 2, wc = wid & 3, fr = lane & 15, fq = lane >> 4;
    const int K = g.K, nt = K / BK;
    unsigned voffA[2], voffB[2];
#pragma unroll
    for (int i = 0; i < 2; ++i) { int R, C; stage_rc(tid * 16 + i * 8192, R, C); const int Rb = Epi::PERM ? ((R & ~31) + perm32(R & 31)) : R;
        voffA[i] = (unsigned)(R * g.lda + C) * 2u; voffB[i] = (unsigned)(Rb * g.ldb + C) * 2u; }
    const size_t kstep = (size_t)(BK * 2);
    const size_t hstepA = (size_t)HALF * g.lda * 2, hstepB = (size_t)HALF * g.ldb * 2;
    const size_t tstepA = 2 * hstepA, tstepB = 2 * hstepB;
    const unsigned ldsw = (unsigned)wid * 1024u;
    const int aoff = lds_byte(wr * 64 + fr, fq * 8), boff = lds_byte(wc * 32 + fr, fq * 8);
#define PG8_SA(b, h) (((b) * 2 + (h)) * HTB)
#define PG8_SB(b, h) ((4 + (b) * 2 + (h)) * HTB)
#define PG8_STAGE(bufoff, gbase, voff) do { _Pragma("unroll") for (int _i = 0; _i < 2; ++_i) \
        __builtin_amdgcn_global_load_lds((const unsigned*)((const char*)(gbase) + (voff)[_i]), (PG8_LAS unsigned*)(lds + (bufoff) + ldsw + _i * 8192), 16, 0, 0); } while (0)
#define PG8_LDA(dst, b, h) do { _Pragma("unroll") for (int m = 0; m < 4; ++m) _Pragma("unroll") for (int k = 0; k < 2; ++k) dst[m][k] = *(const PG8_LAS bf16x8*)(lds + PG8_SA(b, h) + aoff + m * 2048 + k * 1024); } while (0)
#define PG8_LDB(dst, b, h) do { _Pragma("unroll") for (int n = 0; n < 2; ++n) _Pragma("unroll") for (int k = 0; k < 2; ++k) dst[n][k] = *(const PG8_LAS bf16x8*)(lds + PG8_SB(b, h) + boff + n * 2048 + k * 1024); } while (0)
#define PG8_MMA(ai, bj, At, Bt) do { __builtin_amdgcn_s_setprio(1); _Pragma("unroll") for (int m = 0; m < 4; ++m) _Pragma("unroll") for (int n = 0; n < 2; ++n) _Pragma("unroll") for (int k = 0; k < 2; ++k) \
        acc[ai][bj][m][n] = __builtin_amdgcn_mfma_f32_16x16x32_bf16(Bt[n][k], At[m][k], acc[ai][bj][m][n], 0, 0, 0); __builtin_amdgcn_s_setprio(0); } while (0)
#define PG8_WAIT_V(n) asm volatile("s_waitcnt vmcnt(" #n ")" ::: "memory")
#define PG8_WAIT_L(n) asm volatile("s_waitcnt lgkmcnt(" #n ")" ::: "memory")
#define PG8_BAR __builtin_amdgcn_s_barrier()
#define PG8_SCHED __builtin_amdgcn_sched_barrier(0)
    Unit cur, nxt; int ui = 0;
    if (!S.next(0, cur)) return;
    f32x4 acc[2][2][4][2];
#pragma unroll
    for (int a = 0; a < 2; ++a)
#pragma unroll
        for (int b = 0; b < 2; ++b)
#pragma unroll
            for (int m = 0; m < 4; ++m)
#pragma unroll
                for (int n = 0; n < 2; ++n) acc[a][b][m][n] = (f32x4){0.f, 0.f, 0.f, 0.f};
    bf16x8 At[4][2], B0[2][2], B1[2][2];
    const char* cA = (const char*)g.A + (size_t)cur.z * g.zA + (size_t)cur.pm * tstepA; const char* cB = (const char*)g.Bt + (size_t)cur.z * g.zB + (size_t)cur.pn * tstepB;
    S.a_ready(cur);
    if constexpr (SP2) {
        PG8_STAGE(PG8_SB(0, 0), cB, voffB); PG8_STAGE(PG8_SB(0, 1), cB + hstepB, voffB); PG8_STAGE(PG8_SA(0, 0), cA, voffA); PG8_STAGE(PG8_SA(0, 1), cA + hstepA, voffA);
        if (wr == 1) PG8_BAR;
        PG8_WAIT_V(2); PG8_BAR;
        PG8_STAGE(PG8_SB(1, 0), cB + kstep, voffB); PG8_STAGE(PG8_SA(1, 0), cA + kstep, voffA); PG8_STAGE(PG8_SB(1, 1), cB + hstepB + kstep, voffB);
        PG8_WAIT_V(6); PG8_BAR;
    } else {
        PG8_STAGE(PG8_SB(0, 0), cB, voffB); PG8_STAGE(PG8_SA(0, 0), cA, voffA); PG8_STAGE(PG8_SB(0, 1), cB + hstepB, voffB); PG8_STAGE(PG8_SA(0, 1), cA + hstepA, voffA);
        if (wr == 1) PG8_BAR;
        PG8_WAIT_V(4); PG8_BAR;
        PG8_STAGE(PG8_SB(1, 0), cB + kstep, voffB); PG8_STAGE(PG8_SA(1, 0), cA + kstep, voffA); PG8_STAGE(PG8_SB(1, 1), cB + hstepB + kstep, voffB);
        PG8_WAIT_V(6); PG8_BAR;
    }
    for (;;) {
        const bool has_next = S.next(ui + 1, nxt);
        const char* nA = has_next ? (const char*)g.A + (size_t)nxt.z * g.zA + (size_t)nxt.pm * tstepA : cA; const char* nB = has_next ? (const char*)g.Bt + (size_t)nxt.z * g.zB + (size_t)nxt.pn * tstepB : cB;
        for (int t = 0; t < nt; t += 2) {
            const bool last = (t == nt - 2);
            const char* a1 = cA + (size_t)(t + 1) * kstep;
            const char* a2 = last ? nA : cA + (size_t)(t + 2) * kstep; const char* b2 = last ? nB : cB + (size_t)(t + 2) * kstep;
            const char* a3 = a2 + kstep; const char* b3 = b2 + kstep;
            if (last && has_next) S.a_ready(nxt);
            if constexpr (SP2) {
            PG8_LDB(B0, 0, 0); PG8_LDB(B1, 0, 1); PG8_SCHED; PG8_LDA(At, 0, 0); PG8_STAGE(PG8_SA(1, 1), a1 + hstepA, voffA);
            PG8_WAIT_V(8); PG8_WAIT_L(0); PG8_BAR; PG8_MMA(0, 0, At, B0); PG8_MMA(0, 1, At, B1); PG8_BAR; PG8_SCHED;
            PG8_LDA(At, 0, 1); PG8_STAGE(PG8_SB(0, 0), b2, voffB); PG8_STAGE(PG8_SB(0, 1), b2 + hstepB, voffB); PG8_STAGE(PG8_SA(0, 0), a2, voffA);
            PG8_WAIT_V(8); PG8_WAIT_L(0); PG8_BAR; PG8_MMA(1, 0, At, B0); PG8_MMA(1, 1, At, B1); PG8_BAR; PG8_SCHED;
            PG8_LDB(B0, 1, 0); PG8_LDB(B1, 1, 1); PG8_SCHED; PG8_LDA(At, 1, 0); PG8_STAGE(PG8_SA(0, 1), a2 + hstepA, voffA);
            PG8_WAIT_V(8); PG8_WAIT_L(0); PG8_BAR; PG8_MMA(0, 0, At, B0); PG8_MMA(0, 1, At, B1); PG8_BAR; PG8_SCHED;
            PG8_LDA(At, 1, 1); PG8_STAGE(PG8_SB(1, 0), b3, voffB); PG8_STAGE(PG8_SB(1, 1), b3 + hstepB, voffB); PG8_STAGE(PG8_SA(1, 0), a3, voffA);
            PG8_WAIT_V(8); PG8_WAIT_L(0); PG8_BAR; PG8_MMA(1, 0, At, B0); PG8_MMA(1, 1, At, B1); PG8_BAR; PG8_SCHED;
            } else {
            PG8_LDB(B0, 0, 0); PG8_SCHED; PG8_LDA(At, 0, 0); PG8_STAGE(PG8_SA(1, 1), a1 + hstepA, voffA);
            PG8_WAIT_L(8); PG8_BAR; PG8_WAIT_L(0); PG8_MMA(0, 0, At, B0); PG8_BAR; PG8_SCHED;
            PG8_LDB(B1, 0, 1); PG8_STAGE(PG8_SB(0, 0), b2, voffB);
            PG8_BAR; PG8_WAIT_L(0); PG8_MMA(0, 1, At, B1); PG8_BAR;
            PG8_LDA(At, 0, 1); PG8_STAGE(PG8_SA(0, 0), a2, voffA);
            PG8_BAR; PG8_WAIT_L(0); PG8_MMA(1, 0, At, B0); PG8_BAR; PG8_SCHED;
            PG8_STAGE(PG8_SB(0, 1), b2 + hstepB, voffB);
            PG8_WAIT_V(6); PG8_BAR; PG8_MMA(1, 1, At, B1); PG8_BAR;
            PG8_LDB(B0, 1, 0); PG8_SCHED; PG8_LDA(At, 1, 0); PG8_STAGE(PG8_SA(0, 1), a2 + hstepA, voffA);
            PG8_WAIT_L(8); PG8_BAR; PG8_WAIT_L(0); PG8_MMA(0, 0, At, B0); PG8_BAR; PG8_SCHED;
            PG8_LDB(B1, 1, 1); PG8_STAGE(PG8_SB(1, 0), b3, voffB);
            PG8_BAR; PG8_WAIT_L(0); PG8_MMA(0, 1, At, B1); PG8_BAR;
            PG8_LDA(At, 1, 1); PG8_STAGE(PG8_SA(1, 0), a3, voffA);
            PG8_BAR; PG8_WAIT_L(0); PG8_MMA(1, 0, At, B0); PG8_BAR; PG8_SCHED;
            PG8_STAGE(PG8_SB(1, 1), b3 + hstepB, voffB);
            PG8_WAIT_V(6); PG8_BAR; PG8_MMA(1, 1, At, B1); PG8_BAR;
            }
        }
        if constexpr (ALIGN_EPI) { if (wr == 0) PG8_BAR; }
        if constexpr (!Epi::AFTER_DRAIN) { const int t2 = opaque_tid(wv), w2 = __builtin_amdgcn_readfirstlane(t2 >> 6), l2 = t2 & 63; E(acc, cur, w2 >> 2, w2 & 3, l2 & 15, l2 >> 4); S.done(cur); }
        if (!has_next) break;
#pragma unroll
        for (int a = 0; a < 2; ++a)
#pragma unroll
            for (int b = 0; b < 2; ++b)
#pragma unroll
                for (int m = 0; m < 4; ++m)
#pragma unroll
                    for (int n = 0; n < 2; ++n) acc[a][b][m][n] = (f32x4){0.f, 0.f, 0.f, 0.f};
        cur = nxt; cA = nA; cB = nB; ++ui;
        if constexpr (ALIGN_EPI) { if (wr == 1) PG8_BAR; }
    }
    PG8_WAIT_V(0);
    if constexpr (!ALIGN_EPI) { if (wr == 0) PG8_BAR; }
    PG8_BAR;
    if constexpr (Epi::AFTER_DRAIN) { const int t2 = opaque_tid(wv), w2 = __builtin_amdgcn_readfirstlane(t2 >> 6), l2 = t2 & 63; E.fused(acc, cur, w2 >> 2, w2 & 3, l2 & 15, l2 >> 4, lds, w2, l2); S.done(cur); }
#undef PG8_SA
#undef PG8_SB
#undef PG8_STAGE
#undef PG8_LDA
#undef PG8_LDB
#undef PG8_MMA
#undef PG8_WAIT_V
#undef PG8_WAIT_L
#undef PG8_BAR
#undef PG8_SCHED
}

__device__ __forceinline__ void transpose_item(const float* W, const float* gk, int K, int N, bf16_t* WT, int kb, int n0, int orow0, LAS float* scr, int lane) {
    const int k0 = 64 * kb;
    float v[32];
    const float* wp = W + (size_t)(k0 + (lane >> 5)) * N + n0 + (lane & 31);
#pragma unroll
    for (int i = 0; i < 32; ++i) v[i] = __builtin_nontemporal_load(wp + (size_t)(2 * i) * N);
    if (gk) {
#pragma unroll
        for (int i = 0; i < 32; ++i) v[i] *= gk[k0 + 2 * i + (lane >> 5)]; }
#pragma unroll
    for (int i = 0; i < 32; ++i) scr[(2 * i + (lane >> 5)) * 33 + (lane & 31)] = v[i];
    LDS_FENCE();
    const int c = lane & 7;
#pragma unroll
    for (int j = 0; j < 4; ++j) { const int n = (lane >> 3) + 8 * j; const LAS float* s = scr + (8 * c) * 33 + n;
        u32x4 o; o.x = cvt_pk_bf16(s[0 * 33], s[1 * 33]); o.y = cvt_pk_bf16(s[2 * 33], s[3 * 33]); o.z = cvt_pk_bf16(s[4 * 33], s[5 * 33]); o.w = cvt_pk_bf16(s[6 * 33], s[7 * 33]);
        *(u32x4*)(WT + (size_t)(orow0 + n) * K + k0 + 8 * c) = o; }
    LDS_FENCE();
}

__device__ __forceinline__ void build_ssm_mats(int g, int qt, const float* lam_re, const float* lam_im, const float* log_dt, const float* b_re, const float* b_im,
                                               const float* c_re, const float* c_im, const float* dsk, bf16_t* Tt, bf16_t* W1t, LAS unsigned char* lds, int tid) {
    LAS f32x2* pwt = (LAS f32x2*)lds;
    LAS f32x2* bb = (LAS f32x2*)(lds + 16896);
    LAS f32x2* cct = (LAS f32x2*)(lds + 16896 + 8192);
    LAS float* Km = (LAS float*)(lds + 16896 + 16384);
    const float dt = expf(log_dt[g]);
    for (int idx = tid; idx < 64 * 33; idx += NTHREADS) { const int p = idx / 33, d = idx % 33;
        const float re = lam_re[g * 64 + p] * dt * (float)d, im = lam_im[g * 64 + p] * dt * (float)d; const float e = expf(re);
        pwt[idx] = (f32x2){e * cosf(im), e * sinf(im)}; }
    for (int idx = tid; idx < 1024; idx += NTHREADS) { const int p = idx >> 4, hh = idx & 15;
        const float lr = lam_re[g * 64 + p], li = lam_im[g * 64 + p]; const float e = expf(lr * dt);
        const float nr = e * cosf(li * dt) - 1.0f, ni = e * sinf(li * dt), den = 1.0f / (lr * lr + li * li);
        const float kr = (nr * lr + ni * li) * den, ki = (ni * lr - nr * li) * den;
        const float br = b_re[(g * 64 + p) * 16 + hh], bi = b_im[(g * 64 + p) * 16 + hh];
        bb[idx] = (f32x2){kr * br - ki * bi, kr * bi + ki * br};
        cct[idx] = (f32x2){c_re[(g * 16 + hh) * 64 + p], c_im[(g * 16 + hh) * 64 + p]}; }
    __syncthreads();
    { const int d = tid >> 4, hh = tid & 15;
      float a0 = 0.f, a1 = 0.f, a2 = 0.f, a3 = 0.f, a4 = 0.f, a5 = 0.f, a6 = 0.f, a7 = 0.f, a8 = 0.f, a9 = 0.f, a10 = 0.f, a11 = 0.f, a12 = 0.f, a13 = 0.f, a14 = 0.f, a15 = 0.f;
      for (int p = 0; p < 64; ++p) { const f32x2 c = cct[p * 16 + hh], w = pwt[p * 33 + d]; const float wr_ = c.x * w.x - c.y * w.y, wi_ = c.x * w.y + c.y * w.x;
          const LAS f32x2* bp = bb + p * 16;
#define KACC(i, a) { const f32x2 b = bp[i]; a += wr_ * b.x - wi_ * b.y; }
          KACC(0, a0) KACC(1, a1) KACC(2, a2) KACC(3, a3) KACC(4, a4) KACC(5, a5) KACC(6, a6) KACC(7, a7) KACC(8, a8) KACC(9, a9) KACC(10, a10) KACC(11, a11) KACC(12, a12) KACC(13, a13) KACC(14, a14) KACC(15, a15)
#undef KACC
      }
      LAS float* kp = Km + (d * 16 + hh) * 16;
      kp[0] = a0; kp[1] = a1; kp[2] = a2; kp[3] = a3; kp[4] = a4; kp[5] = a5; kp[6] = a6; kp[7] = a7; kp[8] = a8; kp[9] = a9; kp[10] = a10; kp[11] = a11; kp[12] = a12; kp[13] = a13; kp[14] = a14; kp[15] = a15; }
    __syncthreads();
    bf16_t* Tg = Tt + (size_t)g * 512 * KT;
    for (int ch = tid; ch < 128 * 80; ch += NTHREADS) { const int n = qt * 128 + ch / 80, c8 = ch % 80, tau = n >> 4, hh = n & 15, col = c8 * 8;
        f32x4 v0, v1;
        if (col < 512) { const int sig = col >> 4, h0 = col & 15;
#pragma unroll
            for (int e = 0; e < 8; ++e) { const int h2 = h0 + e; float x = (sig <= tau) ? Km[((tau - sig) * 16 + hh) * 16 + h2] : 0.f; if (sig == tau && h2 == hh) x += dsk[g * 16 + hh];
                if (e < 4) v0[e] = x; else v1[e - 4] = x; }
        } else { const int part = (col - 512) >> 6, p0 = (col - 512) & 63;
#pragma unroll
            for (int e = 0; e < 8; ++e) { const int p = p0 + e; const f32x2 c = cct[p * 16 + hh], w = pwt[p * 33 + tau + 1];
                const float x = part == 0 ? (c.x * w.x - c.y * w.y) : -(c.x * w.y + c.y * w.x);
                if (e < 4) v0[e] = x; else v1[e - 4] = x; } }
        *(u32x4*)(Tg + (size_t)n * KT + col) = pack8(v0, v1); }
    bf16_t* Wg = W1t + (size_t)g * 256 * 512;
    for (int ch = tid; ch < 64 * 64; ch += NTHREADS) { const int n = qt * 64 + (ch >> 6), c8 = ch & 63, col = c8 * 8, sig = col >> 4, h0 = col & 15;
        f32x4 v0 = (f32x4){0.f, 0.f, 0.f, 0.f}, v1 = v0;
        if (n < 128) { const int p = n & 63, part = n >> 6; const f32x2 w = pwt[p * 33 + 31 - sig];
#pragma unroll
            for (int e = 0; e < 8; ++e) { const f32x2 b = bb[p * 16 + h0 + e]; const float x = part == 0 ? (w.x * b.x - w.y * b.y) : (w.x * b.y + w.y * b.x);
                if (e < 4) v0[e] = x; else v1[e - 4] = x; } }
        *(u32x4*)(Wg + (size_t)n * 512 + col) = pack8(v0, v1); }
    __syncthreads();
}

__device__ int MAT_TAB[12][7] = {
    {4, 1024, 2816, (int)W_GU1, 1, 0, 3}, {5, 1024, 2816, (int)W_GU1, 2, 1408, 3}, {6, 2816, 1024, (int)W_D1, 0, 2816, -1},
    {25, 1024, 2816, (int)W_GU2, 1, 4224, 24}, {26, 1024, 2816, (int)W_GU2, 2, 5632, 24}, {27, 2816, 1024, (int)W_D2, 0, 7040, -1},
    {9, 1024, 2048, (int)W_IN, 0, 8448, 8}, {19, 512, 512, (int)W_GLU, 0, 9472, -1}, {22, 1024, 1024, (int)W_OUT, 0, 9600, -1}, {30, 1024, 1024, (int)W_PG, 0, 10112, -1},
    {29, 256, 1024, (int)W_PUP, 0, 10624, -1}, {0, 0, 0, 0, 0, 10752, -1}};
template <bool ROT> __device__ __forceinline__ void prep_layer(KA ka, int l, LAS unsigned char* lds, const int wv) {
    const int tid = opaque_tid(wv), wave = __builtin_amdgcn_readfirstlane(tid >> 6), lane = tid & 63; (void)tid; (void)wave; (void)lane;
    unsigned char* ws = kws(ka); unsigned char* wb = ws + WS_W;
    const int G = gridDim.x;
    for (int gq = blockIdx.x; gq < NGRP * 4; gq += G)
        build_ssm_mats(gq >> 2, gq & 3, kin(ka, 11) + l * 2048, kin(ka, 12) + l * 2048, kin(ka, 13) + l * 32, kin(ka, 14) + (size_t)l * 32768, kin(ka, 15) + (size_t)l * 32768, kin(ka, 16) + (size_t)l * 32768,
                       kin(ka, 17) + (size_t)l * 32768, kin(ka, 18) + l * 512, (bf16_t*)(wb + W_T), (bf16_t*)(wb + W_W1), lds, tid);
    LAS float* scr = (LAS float*)(lds + wave * 8448);
    const int gw = blockIdx.x * 8 + wave, NGW = G * 8;
    for (int it = gw; it < 10752; it += NGW) {
        int itv = it; asm volatile("" : "+s"(itv));
        const int m = (itv >= 1408) + (itv >= 2816) + (itv >= 4224) + (itv >= 5632) + (itv >= 7040) + (itv >= 8448) + (itv >= 9472) + (itv >= 9600) + (itv >= 10112) + (itv >= 10624);
        const int in_idx = MAT_TAB[m][0], K = MAT_TAB[m][1], N = MAT_TAB[m][2], woff = MAT_TAB[m][3], mode = MAT_TAB[m][4], r = it - MAT_TAB[m][5]; const int gi = MAT_TAB[m][6];
        const int nb = N >> 5, kb = r / nb, n0 = 32 * (r % nb);
        const int orow0 = mode ? (n0 >> 7) * 256 + (mode - 1) * 128 + (n0 & 127) : n0;
        transpose_item(kin(ka, in_idx) + (size_t)l * K * N, gi >= 0 ? kin(ka, gi) + l * DM : nullptr, K, N, (bf16_t*)(wb + woff), kb, n0, orow0, scr, lane);
    }
    { const f32x4* src = (const f32x4*)(kin(ka, 1) + (size_t)l * MT * PLE); u32x4* dst = (u32x4*)(ws + WS_PB);
      const int nth = G * NTHREADS;
      for (int i0 = blockIdx.x * NTHREADS + tid; i0 < MT * PLE / 8; i0 += 4 * nth) {
          f32x4 t[4][2];
#pragma unroll
          for (int q = 0; q < 4; ++q) { const int i = i0 + q * nth; if (i < MT * PLE / 8) { t[q][0] = __builtin_nontemporal_load(src + 2 * i); t[q][1] = __builtin_nontemporal_load(src + 2 * i + 1); } }
#pragma unroll
          for (int q = 0; q < 4; ++q) { const int i = i0 + q * nth; if (i < MT * PLE / 8) dst[i] = pack8(t[q][0], t[q][1]); } } }
    if constexpr (ROT) {
        const int* pos = (const int*)kin(ka, 2); f32x2* rot = (f32x2*)(ws + WS_ROT);
        const int nth = G * NTHREADS;
        for (int i = blockIdx.x * NTHREADS + tid; i < MT * 8; i += nth) { const int k = i & 7;
            const double f = k == 0 ? 1.0 : k == 1 ? 0.19392274474868576 : k == 2 ? 0.03760603093086393 : k == 3 ? 0.007292664737217109 : k == 4 ? 0.001414213562373095 :
                             k == 5 ? 0.0002742481756762073 : k == 6 ? 5.318295896944988e-05 : 1.031338537721246e-05;
            const double ang = (double)pos[i >> 3] * f; const double kk = rint(ang * 0.15915494309189535); const float rr = (float)(ang - kk * 6.283185307179586);
            rot[i] = (f32x2){cosf(rr), sinf(rr)}; }
    }
}

__device__ __forceinline__ void row_phase(const float* hin, bf16_t* hb, float* rs16, const int wv) {
    const int tid = opaque_tid(wv), wave = __builtin_amdgcn_readfirstlane(tid >> 6), lane = tid & 63; (void)tid;
    const int gw = blockIdx.x * 8 + wave, NGW = gridDim.x * 8;
    for (int row = gw; row < MT; row += NGW) {
        const f32x4* hp = (const f32x4*)(hin + (size_t)row * DM) + lane;
        f32x4 v[4]; float ss = 0.f;
#pragma unroll
        for (int j = 0; j < 4; ++j) { v[j] = __builtin_nontemporal_load(hp + 64 * j); ss += (v[j][0] * v[j][0] + v[j][1] * v[j][1]) + (v[j][2] * v[j][2] + v[j][3] * v[j][3]); }
        ss = wave_sum(ss, lane);
        u32x2* bp = (u32x2*)(hb + (size_t)row * DM) + lane;
#pragma unroll
        for (int j = 0; j < 4; ++j) { u32x2 w; w.x = cvt_pk_bf16(v[j][0], v[j][1]); w.y = cvt_pk_bf16(v[j][2], v[j][3]); bp[64 * j] = w; }
        if (lane < 16) rs16[(size_t)row * 16 + lane] = lane == 0 ? ss : 0.f;
    }
}

__device__ __forceinline__ void mix_rows(const bf16_t* ao, const float* lse, const bf16_t* ssmo, const float* g_attn, const float* g_ssm, bf16_t* xn, const int wv) {
    const int tid = opaque_tid(wv), wave = __builtin_amdgcn_readfirstlane(tid >> 6), lane = tid & 63; (void)tid; (void)wave; (void)lane;
    const int gw = blockIdx.x * 8 + wave, NGW = gridDim.x * 8;
    const int h = lane >> 3;
    const f32x4 ga0 = ((const f32x4*)g_attn)[2 * lane], ga1 = ((const f32x4*)g_attn)[2 * lane + 1], gs0 = ((const f32x4*)g_ssm)[2 * lane], gs1 = ((const f32x4*)g_ssm)[2 * lane + 1];
    for (int row0 = gw; row0 < MT; row0 += 4 * NGW) {
        u32x4 va[4][3], vs[4]; float ll[4][3];
#pragma unroll
        for (int q = 0; q < 4; ++q) { const int row = row0 + q * NGW; if (row < MT) {
#pragma unroll
            for (int p = 0; p < 3; ++p) { va[q][p] = *(const u32x4*)(ao + ((size_t)p * MT + row) * DATT + 8 * lane); ll[q][p] = lse[((size_t)p * MT + row) * 8 + h]; }
            vs[q] = *(const u32x4*)(ssmo + (size_t)row * DSSM + 8 * lane); } }
#pragma unroll
        for (int q = 0; q < 4; ++q) { const int row = row0 + q * NGW; if (row < MT) {
            const float mx = fmaxf(ll[q][0], fmaxf(ll[q][1], ll[q][2]));
            float w0 = __builtin_amdgcn_exp2f(ll[q][0] - mx), w1 = __builtin_amdgcn_exp2f(ll[q][1] - mx), w2 = __builtin_amdgcn_exp2f(ll[q][2] - mx); const float inv = 1.0f / (w0 + w1 + w2); w0 *= inv; w1 *= inv; w2 *= inv;
            f32x4 a0, a1, b0, b1;
            unpack8(va[q][0], a0, a1); a0 *= w0; a1 *= w0;
            unpack8(va[q][1], b0, b1); a0 += b0 * w1; a1 += b1 * w1;
            unpack8(va[q][2], b0, b1); a0 += b0 * w2; a1 += b1 * w2;
            float ss = (a0[0] * a0[0] + a0[1] * a0[1]) + (a0[2] * a0[2] + a0[3] * a0[3]) + (a1[0] * a1[0] + a1[1] * a1[1]) + (a1[2] * a1[2] + a1[3] * a1[3]);
            float rs = 1.0f / sqrtf(wave_sum(ss, lane) * (1.0f / DATT) + EPS);
            *(u32x4*)(xn + (size_t)row * DM + 8 * lane) = pack8(a0 * rs * ga0, a1 * rs * ga1);
            unpack8(vs[q], b0, b1);
            ss = (b0[0] * b0[0] + b0[1] * b0[1]) + (b0[2] * b0[2] + b0[3] * b0[3]) + (b1[0] * b1[0] + b1[1] * b1[1]) + (b1[2] * b1[2] + b1[3] * b1[3]);
            rs = 1.0f / sqrtf(wave_sum(ss, lane) * (1.0f / DSSM) + EPS);
            *(u32x4*)(xn + (size_t)row * DM + DATT + 8 * lane) = pack8(b0 * rs * gs0, b1 * rs * gs1); } }
    }
}

__device__ __forceinline__ void scan_own(int g, int pm, const float* lam_re, const float* lam_im, const float* log_dt, const float* sloc, bf16_t* Ap, LAS unsigned char* lds, const int wv) {
    const int tid = opaque_tid(wv), wave = __builtin_amdgcn_readfirstlane(tid >> 6), lane = tid & 63; (void)tid;
    LAS f32x2* E = (LAS f32x2*)lds;
    const int p = lane;
    asm volatile("s_waitcnt vmcnt(0)" ::: "memory"); __syncthreads();
    const float dt = expf(log_dt[g]); const float lr = lam_re[g * 64 + p] * dt, li = lam_im[g * 64 + p] * dt;
    const float e32 = expf(lr * 32.0f), ar = e32 * cosf(li * 32.0f), ai = e32 * sinf(li * 32.0f);
    const float e512 = expf(lr * 512.0f), br = e512 * cosf(li * 512.0f), bi = e512 * sinf(li * 512.0f);
#pragma unroll 1
    for (int bb = 0; bb < 2; ++bb) { const int b = 2 * pm + bb;
        const float* sp = sloc + ((size_t)g * NCH + b * 128 + 16 * wave) * 128 + p;
        float sr[16], si[16];
#pragma unroll
        for (int c = 0; c < 16; ++c) { sr[c] = __hip_atomic_load(sp + c * 128, __ATOMIC_RELAXED, __HIP_MEMORY_SCOPE_AGENT); si[c] = __hip_atomic_load(sp + c * 128 + 64, __ATOMIC_RELAXED, __HIP_MEMORY_SCOPE_AGENT); }
        float xr = 0.f, xi = 0.f;
#pragma unroll
        for (int c = 0; c < 16; ++c) { const float t = ar * xr - ai * xi + sr[c]; xi = ar * xi + ai * xr + si[c]; xr = t; }
        E[wave * 64 + p] = (f32x2){xr, xi};
        __syncthreads();
        xr = 0.f; xi = 0.f;
        for (int v = 0; v < wave; ++v) { const f32x2 e = E[v * 64 + p]; const float t = br * xr - bi * xi + e.x; xi = br * xi + bi * xr + e.y; xr = t; }
        bf16_t* ap = Ap + ((size_t)g * NCH + b * 128 + 16 * wave) * KT + 512 + p;
#pragma unroll
        for (int c = 0; c < 16; ++c) { ap[c * KT] = f2bf(xr); ap[c * KT + 64] = f2bf(xi);
            const float t = ar * xr - ai * xi + sr[c]; xi = ar * xi + ai * xr + si[c]; xr = t; }
        __syncthreads();
    }
}

constexpr int AT_KS = 128 * 72, AT_VS = 64 * 140;
__device__ __forceinline__ void attn_phase(const bf16_t* qkv, bf16_t* ao, float* lse, unsigned* queue, LAS unsigned char* lds, const int wv) {
    const int tid = opaque_tid(wv), wave = __builtin_amdgcn_readfirstlane(tid >> 6), lane = tid & 63;
    LAS bf16_t* Ks = (LAS bf16_t*)lds;
    LAS bf16_t* Vt = (LAS bf16_t*)(lds + 2 * AT_KS * 2);
    const int fr = lane & 15, fq = lane >> 4;
    const int lrow = tid >> 2, lseg = tid & 3;
    const int vpair = tid >> 3, vch = tid & 7;
    const int qi = 16 * wave + fr, kb0 = 32 * (wave >> 1);
    volatile LAS unsigned* qslot = (volatile LAS unsigned*)(lds + STAGE_BYTES + 32);
    for (;;) {
        if (tid == 0) qslot[0] = __hip_atomic_fetch_add(queue, 1u, __ATOMIC_RELAXED, __HIP_MEMORY_SCOPE_AGENT);
        asm volatile("s_waitcnt vmcnt(0) lgkmcnt(0)" ::: "memory"); __builtin_amdgcn_s_barrier(); asm volatile("" ::: "memory");
        const int item = (int)qslot[0];
        if (item >= NB * NHEAD * 12) break;
        const int bh = item / 12, sub = item % 12, kind = sub >> 2, q = sub & 3;
        const int b = bh >> 3, h = bh & 7;
        const bf16_t* base = qkv + (size_t)b * SEQ * QKVW + h * 64;
        const int pre = (kind == 0 && q > 0) ? 1 : 0, nent = 8 + pre;
        const int d = kind == 0 ? 1 : (kind == 1 ? 4 : 16);
        u32x4 k0, k1, v0, v1; bf16x8 qn0, qn1, qc0, qc1;
#define AT_ENTRY(j_, r_, bi_) const int e_ = (j_) - pre; const int r_ = kind == 0 ? 0 : (kind == 1 ? q : 4 * q + (e_ >> 1)); const int bi_ = kind == 0 ? 8 * q + e_ : (kind == 1 ? e_ : (e_ & 1));
#define AT_LOAD(j_) do { AT_ENTRY(j_, r__, bi__) \
            const bf16_t* src = base + (size_t)((128 * bi__ + lrow) * d + r__) * QKVW + lseg * 16; \
            k0 = *(const u32x4*)(src + 512); k1 = *(const u32x4*)(src + 520); \
            const bf16_t* vsrc = base + (size_t)((128 * bi__ + 2 * vpair) * d + r__) * QKVW + 1024 + vch * 8; v0 = *(const u32x4*)vsrc; v1 = *(const u32x4*)(vsrc + (size_t)d * QKVW); \
            const bf16_t* qp = base + (size_t)((128 * bi__ + qi) * d + r__) * QKVW + 8 * fq; qn0 = *(const bf16x8*)qp; qn1 = *(const bf16x8*)(qp + 32); } while (0)
        AT_LOAD(0);
        for (int j = 0; j < nent; ++j) {
            AT_ENTRY(j, r, bi)
            const int slot = bi & 1;
            asm volatile("s_waitcnt lgkmcnt(0)" ::: "memory"); __builtin_amdgcn_s_barrier(); asm volatile("" ::: "memory");
            { LAS bf16_t* kd = Ks + slot * AT_KS + lrow * 72 + lseg * 16; *(LAS u32x4*)kd = k0; *(LAS u32x4*)(kd + 8) = k1;
              LAS unsigned* vd = (LAS unsigned*)(Vt + slot * AT_VS + (vch * 8) * 140 + 2 * vpair);
#pragma unroll
              for (int e = 0; e < 4; ++e) { vd[(2 * e) * 70] = (v0[e] & 0xffffu) | (v1[e] << 16); vd[(2 * e + 1) * 70] = (v0[e] >> 16) | (v1[e] & 0xffff0000u); } }
            qc0 = qn0; qc1 = qn1;
            if (j + 1 < nent) AT_LOAD(j + 1);
            asm volatile("s_waitcnt lgkmcnt(0)" ::: "memory"); __builtin_amdgcn_s_barrier(); asm volatile("" ::: "memory");
            if (j >= pre) {
                f32x4 s[10];
#pragma unroll
                for (int t = 0; t < 10; ++t) { const int kj0 = kb0 + 16 * t;
                    if ((kj0 < 128 && bi == 0) || (t == 0 && (wave & 1)) || (t == 9 && !(wave & 1))) { s[t] = (f32x4){-INFINITY, -INFINITY, -INFINITY, -INFINITY}; }
                    else { const int sl = kj0 < 128 ? (slot ^ 1) : slot;
                        const LAS bf16_t* kp = Ks + sl * AT_KS + ((kj0 & 127) + fr) * 72 + 8 * fq;
                        const bf16x8 ka = *(const LAS bf16x8*)kp, kb = *(const LAS bf16x8*)(kp + 32);
                        f32x4 z = (f32x4){0.f, 0.f, 0.f, 0.f};
                        z = __builtin_amdgcn_mfma_f32_16x16x32_bf16(ka, qc0, z, 0, 0, 0); z = __builtin_amdgcn_mfma_f32_16x16x32_bf16(kb, qc1, z, 0, 0, 0);
#pragma unroll
                        for (int jj = 0; jj < 4; ++jj) { const int kj = kj0 + 4 * fq + jj;
                            if (t <= 1) z[jj] = (kj >= qi) ? z[jj] : -INFINITY;
                            if (t >= 8) z[jj] = (kj <= qi + 128) ? z[jj] : -INFINITY; }
                        s[t] = z; } }
                float mx = -INFINITY;
#pragma unroll
                for (int t = 0; t < 10; ++t) mx = fmaxf(mx, fmaxf(fmaxf(s[t][0], s[t][1]), fmaxf(s[t][2], s[t][3])));
                mx = fmaxf(mx, shx(mx, 16, lane)); mx = fmaxf(mx, shx(mx, 32, lane));
                float l = 0.f;
#pragma unroll
                for (int t = 0; t < 10; ++t)
#pragma unroll
                    for (int jj = 0; jj < 4; ++jj) { const float pv = __builtin_amdgcn_exp2f(s[t][jj] - mx); s[t][jj] = pv; l += pv; }
                l += shx(l, 16, lane); l += shx(l, 32, lane);
                f32x4 o[4];
#pragma unroll
                for (int dt = 0; dt < 4; ++dt) o[dt] = (f32x4){0.f, 0.f, 0.f, 0.f};
#pragma unroll
                for (int g = 0; g < 5; ++g) { const int key0 = kb0 + 32 * g;
                    if (!(key0 < 128 && bi == 0)) { const int sl = key0 < 128 ? (slot ^ 1) : slot;
                        const u32x4 pw = pack8(s[2 * g], s[2 * g + 1]); const bf16x8 pf = __builtin_bit_cast(bf16x8, pw);
#pragma unroll
                        for (int dt = 0; dt < 4; ++dt) { const LAS bf16_t* vp = Vt + sl * AT_VS + (16 * dt + fr) * 140 + (key0 & 127) + 4 * fq;
                            const u32x2 va = *(const LAS u32x2*)vp, vb = *(const LAS u32x2*)(vp + 16);
                            const bf16x8 vf = __builtin_bit_cast(bf16x8, (u32x4){va.x, va.y, vb.x, vb.y});
                            o[dt] = __builtin_amdgcn_mfma_f32_16x16x32_bf16(vf, pf, o[dt], 0, 0, 0); } } }
                const float inv = 1.0f / l;
                const size_t orow = (size_t)kind * MT + (size_t)b * SEQ + (size_t)((128 * bi + qi) * d + r);
                bf16_t* op = ao + orow * DATT + h * 64 + 4 * fq;
#pragma unroll
                for (int dt = 0; dt < 4; ++dt) { u32x2 w; w.x = cvt_pk_bf16(o[dt][0] * inv, o[dt][1] * inv); w.y = cvt_pk_bf16(o[dt][2] * inv, o[dt][3] * inv); *(u32x2*)(op + 16 * dt) = w; }
                if (fq == 0) lse[orow * 8 + h] = mx + __builtin_amdgcn_logf(l);
            }
        }
#undef AT_LOAD
#undef AT_ENTRY
    }
    asm volatile("s_waitcnt lgkmcnt(0)" ::: "memory"); __builtin_amdgcn_s_barrier(); asm volatile("" ::: "memory");
}

#define XB_TMO      128
#define XB_XCNT(j)  (256  + 64 * (j))
#define XB_XSUB(j)  (1280 + 64 * (j))
#define XB_XGEN(j)  (2304 + 64 * (j))
#define XB_TOP      3328
#define XB_TOPGEN   3392
#define XCD_BAR_WORDS 3456
#define XB_SPIN_CAP (1u << 18)

__device__ __forceinline__ unsigned xb_ld(unsigned* p)              { return __hip_atomic_load(p, __ATOMIC_RELAXED, __HIP_MEMORY_SCOPE_AGENT); }
__device__ __forceinline__ unsigned xb_add(unsigned* p, unsigned v) { return __hip_atomic_fetch_add(p, v, __ATOMIC_RELAXED, __HIP_MEMORY_SCOPE_AGENT); }
__device__ __forceinline__ unsigned xb_xcc_id() { return (unsigned)__builtin_amdgcn_s_getreg((3 << 11) | 20) & 0xFu; }
#define XB_SPIN(cond, bar) do { unsigned _sp = 0; while (cond) { __builtin_amdgcn_s_sleep(1); \
    if ((++_sp & 255u) == 0u) { if (xb_ld(&(bar)[XB_TMO])) break; if (_sp > XB_SPIN_CAP) { atomicAdd(&(bar)[XB_TMO], 1u); break; } } } } while (0)

struct XcdBarrier {
    unsigned* bar; unsigned x;
    volatile LAS unsigned* st;
};

__device__ __forceinline__ XcdBarrier xcd_barrier_post(unsigned* bar, volatile LAS unsigned* st) {
    XcdBarrier b; b.bar = bar; b.x = xb_xcc_id(); b.st = st;
    if (threadIdx.x == 0) (void)xb_add(&bar[XB_XCNT(b.x)], 1u);
    return b;
}
__device__ __forceinline__ void xcd_barrier_complete(unsigned* bar, unsigned x, unsigned& nloc, unsigned& nx) {
    const unsigned G = gridDim.x * gridDim.y * gridDim.z;
    unsigned sum, cnt, mine, sp = 0u;
    for (;;) {
        sum = 0u; cnt = 0u; mine = 0u;
#pragma unroll
        for (unsigned j = 0; j < 16; ++j) { const unsigned c = xb_ld(&bar[XB_XCNT(j)]); sum += c; cnt += (c > 0u) ? 1u : 0u; mine = (j == x) ? c : mine; }
        if (sum == G) break;
        __builtin_amdgcn_s_sleep(1);
        if ((++sp & 255u) == 0u) { if (xb_ld(&bar[XB_TMO])) break; if (sp > XB_SPIN_CAP) { atomicAdd(&bar[XB_TMO], 1u); break; } }
    }
    nloc = mine > 0u ? mine : 1u; nx = cnt > 0u ? cnt : 1u;
}

__device__ __forceinline__ void xcd_barrier(const XcdBarrier& b, const int wv) {
    asm volatile("s_waitcnt vmcnt(0)" ::: "memory");
    __syncthreads();
    if (opaque_tid(wv) == 0) {
        unsigned* bar = b.bar;
        __builtin_amdgcn_s_waitcnt(0);
        unsigned nloc = b.st[0], nx = b.st[1];
        if (nloc == 0u) { xcd_barrier_complete(bar, b.x, nloc, nx); b.st[0] = nloc; b.st[1] = nx; }
        const unsigned old = xb_add(&bar[XB_XSUB(b.x)], 1u);
        const unsigned gen = old / nloc;
        if (old + 1u == (gen + 1u) * nloc) {
            __builtin_amdgcn_fence(__ATOMIC_RELEASE, "agent");
            asm volatile("s_waitcnt vmcnt(0)" ::: "memory");
            const unsigned og = xb_add(&bar[XB_TOP], 1u);
            const unsigned tg = og / nx;
            if (og + 1u == (tg + 1u) * nx) xb_add(&bar[XB_TOPGEN], 1u);
            else XB_SPIN(xb_ld(&bar[XB_TOPGEN]) == tg, bar);
            __builtin_amdgcn_fence(__ATOMIC_ACQUIRE, "agent");
            xb_add(&bar[XB_XGEN(b.x)], 1u);
            asm volatile("s_waitcnt vmcnt(0)" ::: "memory");
        } else {
            XB_SPIN(xb_ld(&bar[XB_XGEN(b.x)]) == gen, bar);
            __builtin_amdgcn_fence(__ATOMIC_ACQUIRE, "agent");
            asm volatile("s_waitcnt vmcnt(0)" ::: "memory");
        }
    }
    __syncthreads();
}


#define GEMM_RUN(EpiT_, SchedT_, g_, S_, E_) gemm_phase<EpiT_, SchedT_, true, true>(lds, g_, S_, E_, wv)
__device__ __forceinline__ void fused_gemm(LAS unsigned char* lds, const bf16_t* A, int lda, const bf16_t* Bt, int K, bf16_t* H, float* OUTF, float* RS, const bf16_t* UP, const float* gpost,
                                           float scale, int xmode, unsigned char* xw, unsigned use1, unsigned use2, int G, int c, const int wv) {
    Gemm g{A, Bt, lda, K, K, 0, 0}; StaticOrder S; S.init(MT, DM, G, c);
    EpiFuse E{lds, 0, H, OUTF, RS, UP, gpost, scale, xmode, xw, use1 + 1u, use2 + 1u};
    gemm_phase<EpiFuse, StaticOrder, true, true>(lds, g, S, E, wv);
}
struct Ptrs { unsigned char *ws, *wb, *xw; float* RS; bf16_t *HB, *XN, *F, *PB, *ACT, *QKV, *AP, *YG, *SSMO, *AO; float *SLOC, *LSE; };
__device__ __forceinline__ Ptrs mkptrs(unsigned char* ws) {
    asm volatile("" : "+s"(ws));
    Ptrs P; P.ws = ws; P.wb = ws + WS_W; P.xw = ws + WS_EXCH; unsigned char* big = ws + WS_BIG;
    P.RS = (float*)(ws + WS_RS); P.HB = (bf16_t*)(ws + WS_HB); P.XN = (bf16_t*)(ws + WS_XN); P.F = (bf16_t*)(big + B_AO);     P.PB = (bf16_t*)(ws + WS_PB);
    P.ACT = (bf16_t*)(big + B_ACT); P.QKV = (bf16_t*)(big + B_QKV); P.AP = (bf16_t*)(big + B_AP); P.SLOC = (float*)(big + B_SLOC);
    P.YG = (bf16_t*)(big + B_YG); P.SSMO = (bf16_t*)(big + B_SSMO); P.AO = (bf16_t*)(big + B_AO); P.LSE = (float*)(big + B_LSE);
    return P;
}
#define PH_BEGIN const KA ka = kargs(); const Ptrs P = mkptrs(kws(ka)); float* H = kout(ka); (void)H; int l = l_; asm volatile("" : "+s"(l)); int G = gridDim.x, c = blockIdx.x; asm volatile("" : "+s"(G), "+s"(c)); (void)G; (void)c; (void)l; (void)P

__global__ void __launch_bounds__(NTHREADS, 2) hybrid_fwd(Args a) {
    extern __shared__ __attribute__((aligned(16))) unsigned char lds_raw[];
    LAS unsigned char* lds = (LAS unsigned char*)lds_raw;
    cg::grid_group grid = cg::this_grid();
    const int wv = __builtin_amdgcn_readfirstlane((int)threadIdx.x >> 6);
    volatile LAS unsigned* xst = (volatile LAS unsigned*)(lds + STAGE_BYTES);
    if (threadIdx.x == 0) { xst[0] = 0u; xst[1] = 0u; }
    __syncthreads();
    const XcdBarrier xb = xcd_barrier_post((unsigned*)(kws(kargs()) + WS_EXCH + X_BAR), xst);
    { const int l_ = 0; PH_BEGIN;
      prep_layer<true>(ka, 0, lds, wv);
      row_phase(kin(ka, 0), P.HB, P.RS, wv); }
    grid.sync();

#pragma unroll 1
    for (int l_ = 0; l_ < DEPTH; ++l_) {
        { PH_BEGIN; Gemm g{P.HB, (const bf16_t*)(P.wb + W_GU1), DM, DM, DM, 0, 0}; StaticOrder S; S.init(MT, 2 * DFF, G, c); EpiSwiglu E{P.ACT, P.RS}; GEMM_RUN(EpiSwiglu, StaticOrder, g, S, E); }
        xcd_barrier(xb, wv);
        { PH_BEGIN; fused_gemm(lds, P.ACT, DFF, (const bf16_t*)(P.wb + W_D1), DFF, P.HB, nullptr, P.RS, nullptr, kin(ka, 7) + l * DM, 0.5f, 1, P.xw, 4u * l + 0u, 3u * l + 0u, G, c, wv); }
        xcd_barrier(xb, wv);
        { PH_BEGIN; Gemm g{P.HB, (const bf16_t*)(P.wb + W_IN), DM, DM, DM, 0, 0}; StaticOrder S; S.init(MT, DIN, G, c); EpiWin E{P.QKV, P.AP, (const f32x4*)(P.ws + WS_ROT), P.RS}; GEMM_RUN(EpiWin, StaticOrder, g, S, E); }
        xcd_barrier(xb, wv);
        { PH_BEGIN; Gemm g{P.AP, (const bf16_t*)(P.wb + W_W1), KT, 512, 512, (size_t)NCH * KT * 2, (size_t)256 * 512 * 2}; BatchOrder S{4, 1, NGRP, G, c}; EpiSloc E{P.SLOC}; GEMM_RUN(EpiSloc, BatchOrder, g, S, E);
          if (c < NGRP * 4) scan_own(c >> 2, c & 3, kin(ka, 11) + l * 2048, kin(ka, 12) + l * 2048, kin(ka, 13) + l * 32, P.SLOC, P.AP, lds, wv); }
        { PH_BEGIN; asm volatile("s_waitcnt vmcnt(0)" ::: "memory"); __syncthreads();
          Gemm g{P.AP, (const bf16_t*)(P.wb + W_T), KT, KT, KT, (size_t)NCH * KT * 2, (size_t)512 * KT * 2}; OwnTOrder S{c >> 2, c & 3, c < NGRP * 4}; EpiT E{P.YG}; GEMM_RUN(EpiT, OwnTOrder, g, S, E); }
        { PH_BEGIN; attn_phase(P.QKV, P.AO, P.LSE, (unsigned*)(P.xw + X_CNT) + 64 * l, lds, wv); }
        xcd_barrier(xb, wv);
        { PH_BEGIN; Gemm g{P.YG, (const bf16_t*)(P.wb + W_GLU), DSSM, DSSM, DSSM, 0, 0}; StaticOrder S; S.init(MT, DSSM, G, c); EpiGlu E{P.YG, kin(ka, 20) + l * DSSM, P.SSMO}; GEMM_RUN(EpiGlu, StaticOrder, g, S, E); }
        xcd_barrier(xb, wv);
        { PH_BEGIN; mix_rows(P.AO, P.LSE, P.SSMO, kin(ka, 10) + l * DATT, kin(ka, 21) + l * DSSM, P.XN, wv); }
        xcd_barrier(xb, wv);
        { PH_BEGIN; fused_gemm(lds, P.XN, DM, (const bf16_t*)(P.wb + W_OUT), DM, P.HB, nullptr, P.RS, nullptr, kin(ka, 23) + l * DM, 1.0f, 1, P.xw, 4u * l + 1u, 3u * l + 1u, G, c, wv); }
        xcd_barrier(xb, wv);
        { PH_BEGIN; Gemm g{P.HB, (const bf16_t*)(P.wb + W_GU2), DM, DM, DM, 0, 0}; StaticOrder S; S.init(MT, 2 * DFF, G, c); EpiSwiglu E{P.ACT, P.RS}; GEMM_RUN(EpiSwiglu, StaticOrder, g, S, E); }
        { PH_BEGIN; Gemm g{P.PB, (const bf16_t*)(P.wb + W_PUP), PLE, PLE, PLE, 0, 0}; StaticOrder S; S.init(MT, DM, G, c); EpiBf16 E{P.F, DM}; GEMM_RUN(EpiBf16, StaticOrder, g, S, E); }
        xcd_barrier(xb, wv);
        { PH_BEGIN; fused_gemm(lds, P.ACT, DFF, (const bf16_t*)(P.wb + W_D2), DFF, P.HB, nullptr, P.RS, nullptr, kin(ka, 28) + l * DM, 0.5f, 0, P.xw, 4u * l + 2u, 0u, G, c, wv); }
        xcd_barrier(xb, wv);
        { PH_BEGIN; fused_gemm(lds, P.HB, DM, (const bf16_t*)(P.wb + W_PG), DM, P.HB, l + 1 < DEPTH ? nullptr : H, P.RS, P.F, kin(ka, 31) + l * DM, 1.0f, l + 1 < DEPTH ? 1 : 0, P.xw, 4u * l + 3u, 3u * l + 2u, G, c, wv); }
        if (l_ + 1 < DEPTH) {
            xcd_barrier(xb, wv);
            { PH_BEGIN; prep_layer<false>(ka, l + 1, lds, wv); }
            xcd_barrier(xb, wv);
        }
    }
}

extern "C" void kernel_launch(void* const* d_in, const int* in_sizes, int n_in, void* d_out, int out_size, void* d_ws, size_t ws_size, hipStream_t stream) {
    static int grid = 0;
    if (grid == 0) {
        if (n_in != 32 || out_size != MT * DM || ws_size < WS_END) { fprintf(stderr, "kernel_launch: unexpected shapes (n_in %d out %d ws %zu, need %zu)\n", n_in, out_size, ws_size, (size_t)WS_END); grid = -1; return; }
        int dev = 0, cus = 0, per_cu = 0;
        if (hipGetDevice(&dev) != hipSuccess || hipDeviceGetAttribute(&cus, hipDeviceAttributeMultiprocessorCount, dev) != hipSuccess) { grid = -1; return; }
        if (hipFuncSetAttribute((const void*)hybrid_fwd, hipFuncAttributeMaxDynamicSharedMemorySize, LDS_BYTES) != hipSuccess) { fprintf(stderr, "kernel_launch: hipFuncSetAttribute failed\n"); grid = -1; return; }
        if (hipOccupancyMaxActiveBlocksPerMultiprocessor(&per_cu, (const void*)hybrid_fwd, NTHREADS, LDS_BYTES) != hipSuccess || per_cu < 1) { fprintf(stderr, "kernel_launch: occupancy query says %d\n", per_cu); per_cu = 1; }
        (void)hipGetLastError();
        grid = cus * 1; if (grid != 256) fprintf(stderr, "kernel_launch: built for 256 CUs, got %d\n", grid);
    }
    if (grid < 0) return;
    if (hipMemsetAsync((unsigned char*)d_ws + WS_EXCH, 0, X_BAR + 16384, stream) != hipSuccess) { fprintf(stderr, "kernel_launch: memset failed\n"); return; }
    Args a{};
    for (int i = 0; i < 32; ++i) a.in[i] = (const float*)d_in[i];
    a.out = (float*)d_out; a.ws = (unsigned char*)d_ws;
    void* args[] = {&a};
    hipError_t e = hipLaunchCooperativeKernel((const void*)hybrid_fwd, dim3(grid), dim3(NTHREADS), args, LDS_BYTES, stream);
    if (e != hipSuccess) fprintf(stderr, "cooperative launch failed: %s (grid %d)\n", hipGetErrorString(e), grid);
}
```
